# Optimizing an MI355X kernel written in HIP

```python
import jax
import jax.numpy as jnp
from jax import lax
import numpy as np

D_MODEL = 1024
BATCH = 32
SEQ = 256
DEPTH = 4
DEC_BATCH = 4
DEC_SEQ = 1024
PAST_LEN = 256

GRID_W = 64
HEAD_DIM = 64
GROUP_W = D_MODEL // 4
MIX_W = 4 * GROUP_W
LRU_W = GROUP_W
LRU_BLOCKS = 4
CONV_W = 4
LRU_C = 8.0
GQA_HEADS = GROUP_W // HEAD_DIM
GQA_KV = GQA_HEADS // 2
NAT_HEADS = GROUP_W // HEAD_DIM
NAT_WR = 8
NAT_WC = 16
RET_HEADS = GROUP_W // HEAD_DIM
RET_CHUNK = 128
D_FF = 11 * D_MODEL // 4
Q_BLOCK = 128
ROPE_BASE = 10000.0
EPS = 1e-6
NEG_INF = -1e30
N_MOD = 9
COL_WIDTHS = (LRU_W, LRU_W,
              GQA_HEADS * HEAD_DIM, GQA_KV * HEAD_DIM, GQA_KV * HEAD_DIM,
              GROUP_W, GROUP_W, GROUP_W,
              GROUP_W, GROUP_W, GROUP_W, GROUP_W)
IN_COLS = 2 * LRU_W + (GQA_HEADS + 2 * GQA_KV) * HEAD_DIM + 3 * GROUP_W + 4 * GROUP_W

kernel_name = 'hybrid_diffusion_prefix_trunk_step'

f32 = jnp.float32


def rmsnorm(x, g):
    xf = x.astype(f32)
    y = xf * lax.rsqrt(jnp.mean(xf * xf, axis=-1, keepdims=True) + EPS)
    return (y * g).astype(x.dtype)


def heads(x, n):
    return x.reshape(*x.shape[:-1], n, HEAD_DIM)


def split_columns(h):
    bounds, acc = [], 0
    for w in COL_WIDTHS[:-1]:
        acc += w
        bounds.append(acc)
    return jnp.split(h, bounds, axis=-1)


def swiglu(x, w_in, w_out):
    a, b = jnp.split(x @ w_in, 2, axis=-1)
    return (jax.nn.silu(a) * b) @ w_out


def adaln(cvec, w_mod, b_mod):
    m = jax.nn.silu(cvec) @ w_mod + b_mod
    return jnp.split(m[:, None, :], N_MOD, axis=-1)


def axial_rope(T):
    t = jnp.arange(T)
    row = (t // GRID_W).astype(f32)
    col = (t % GRID_W).astype(f32)
    n_freq = HEAD_DIM // 4
    inv = ROPE_BASE ** (-jnp.arange(n_freq, dtype=f32) / n_freq)
    ang = jnp.concatenate([row[:, None] * inv, col[:, None] * inv], axis=-1)
    return jnp.cos(ang), jnp.sin(ang)


def apply_rope(x, cos, sin):
    xf = x.astype(f32)
    x1, x2 = xf[..., 0::2], xf[..., 1::2]
    c, s = cos[None, :, None, :], sin[None, :, None, :]
    return jnp.stack([x1 * c - x2 * s, x1 * s + x2 * c], axis=-1).reshape(x.shape).astype(x.dtype)


def gqa_attend(q, k, v):
    B, T, H, D = q.shape
    KV = k.shape[2]
    G = H // KV
    nb = T // Q_BLOCK
    qb = q.reshape(B, nb, Q_BLOCK, KV, G, D).transpose(1, 0, 2, 3, 4, 5)
    scale = D ** -0.5

    def one_block(qblk):
        s = jnp.einsum('bqkgd,bskd->bkgqs', qblk, k, preferred_element_type=f32) * scale
        p = jax.nn.softmax(s, axis=-1).astype(v.dtype)
        return jnp.einsum('bkgqs,bskd->bqkgd', p, v)

    o = lax.map(one_block, qb)
    return o.transpose(1, 0, 2, 3, 4, 5).reshape(B, T, H * D)


def neighbourhood_attend(q, k, v, k_ctx, v_ctx, bias_tab):
    B, T, H, D = q.shape
    R = T // GRID_W
    wr = min(NAT_WR, R)
    rows = jnp.arange(R)
    rs = jnp.clip(rows - wr // 2, 0, R - wr)
    row_idx = rs[:, None] + jnp.arange(wr)[None, :]
    cols = jnp.arange(GRID_W)
    cs = jnp.clip(cols - NAT_WC // 2, 0, GRID_W - NAT_WC)
    in_win = (cols[None, :] >= cs[:, None]) & (cols[None, :] < cs[:, None] + NAT_WC)
    dr = row_idx - rows[:, None] + (NAT_WR - 1)
    dc = jnp.clip(cols[None, :] - cols[:, None] + (NAT_WC - 1), 0, 2 * NAT_WC - 2)
    bias = bias_tab[:, dr[:, None, :, None], dc[None, :, None, :]]
    qg = q.reshape(B, R, GRID_W, H, D)
    kg = k.reshape(B, R, GRID_W, H, D)[:, row_idx]
    vg = v.reshape(B, R, GRID_W, H, D)[:, row_idx]
    scale = D ** -0.5
    s_loc = jnp.einsum('brqhd,brwkhd->bhrqwk', qg, kg, preferred_element_type=f32) * scale
    s_loc = jnp.where(in_win[None, None, None, :, None, :], s_loc + bias[None].astype(f32), NEG_INF)
    s_ctx = jnp.einsum('brqhd,bshd->bhrqs', qg, k_ctx, preferred_element_type=f32) * scale
    n_loc = wr * GRID_W
    p = jax.nn.softmax(jnp.concatenate([s_loc.reshape(B, H, R, GRID_W, n_loc), s_ctx], axis=-1), axis=-1)
    p = p.astype(v.dtype)
    p_loc = p[..., :n_loc].reshape(B, H, R, GRID_W, wr, GRID_W)
    p_ctx = p[..., n_loc:]
    o = (jnp.einsum('bhrqwk,brwkhd->brqhd', p_loc, vg)
         + jnp.einsum('bhrqs,bshd->brqhd', p_ctx, v_ctx))
    return o.reshape(B, T, H * D)


def conv_centred(x, w, b):
    T = x.shape[1]
    left = CONV_W // 2
    xp = jnp.pad(x, ((0, 0), (left, CONV_W - 1 - left), (0, 0)))
    y = xp[:, 0:T] * w[0]
    for i in range(1, CONV_W):
        y = y + xp[:, i:i + T] * w[i]
    return y + b


def _lin_combine(left, right):
    a_l, b_l = left
    a_r, b_r = right
    return a_l * a_r, a_r * b_l + b_r


def rglru_mixer(xa, ga, conv_w, conv_b, w_r, b_r, w_i, b_i, lam, h0):
    xc = conv_centred(xa, conv_w, conv_b).astype(f32)
    B, T, W = xc.shape
    xb = xc.reshape(B, T, LRU_BLOCKS, W // LRU_BLOCKS)
    hs = []
    for d in range(2):
        r = jax.nn.sigmoid(jnp.einsum('btnc,ncd->btnd', xb, w_r[d].astype(f32)).reshape(B, T, W) + b_r[d])
        i = jax.nn.sigmoid(jnp.einsum('btnc,ncd->btnd', xb, w_i[d].astype(f32)).reshape(B, T, W) + b_i[d])
        log_a = -LRU_C * r * jax.nn.softplus(-lam[d].astype(f32))
        a = jnp.exp(log_a)
        u = jnp.sqrt(-jnp.expm1(2.0 * log_a)) * (i * xc)
        A, Bc = lax.associative_scan(_lin_combine, (a, u), axis=1, reverse=(d == 1))
        hs.append(A * h0[:, d, None, :].astype(f32) + Bc)
    y = (hs[0] + hs[1]) * jax.nn.gelu(ga.astype(f32))
    return y.astype(xa.dtype), hs[0][:, -1], hs[1][:, 0]


def retention_scan(q, k, v, log_g, S0):
    B, T, H, D = q.shape
    n = T // RET_CHUNK
    pos = jnp.arange(RET_CHUNK, dtype=f32)
    diff = pos[:, None] - pos[None, :]
    dmat = jnp.where(diff >= 0, jnp.exp(log_g[:, None, None] * jnp.maximum(diff, 0.0)), 0.0)
    xi = jnp.exp(log_g[None, :] * (pos[:, None] + 1.0))
    zeta = jnp.exp(log_g[None, :] * (RET_CHUNK - 1.0 - pos[:, None]))
    g_chunk = jnp.exp(log_g * RET_CHUNK)

    def chunks(t):
        return t.reshape(B, n, RET_CHUNK, H, D).swapaxes(0, 1)

    def step(S, blk):
        qb, kb, vb = blk
        s = jnp.einsum('bqhd,bkhd->bhqk', qb, kb) * dmat
        o = (jnp.einsum('bhqk,bkhe->bqhe', s, vb)
             + jnp.einsum('bqhd,bhde->bqhe', qb, S) * xi[None, :, :, None])
        S = S * g_chunk[None, :, None, None] + jnp.einsum('bkhd,kh,bkhe->bhde', kb, zeta, vb)
        return S, o

    S, o = lax.scan(step, S0, (chunks(q), chunks(k), chunks(v)))
    return o.swapaxes(0, 1).reshape(B, T, H, D), S


def retention_mixer(qd, kd, vd, gd, decay_logit, gn_g, S0):
    B, T, _ = qd.shape
    q = heads(qd, RET_HEADS).astype(f32)
    k = heads(kd, RET_HEADS).astype(f32) * (HEAD_DIM ** -0.5)
    v = heads(vd, RET_HEADS).astype(f32)
    log_g = jax.nn.log_sigmoid(decay_logit.astype(f32))
    o_f, S_f = retention_scan(q, k, v, log_g[0], S0[:, 0].astype(f32))
    o_b, S_b = retention_scan(jnp.flip(q, 1), jnp.flip(k, 1), jnp.flip(v, 1), log_g[1], S0[:, 1].astype(f32))
    o = o_f + jnp.flip(o_b, 1)
    mu = jnp.mean(o, axis=-1, keepdims=True)
    var = jnp.mean(jnp.square(o - mu), axis=-1, keepdims=True)
    o = ((o - mu) * lax.rsqrt(var + EPS)).reshape(B, T, RET_HEADS * HEAD_DIM) * gn_g
    y = o * jax.nn.silu(gd.astype(f32))
    return y.astype(qd.dtype), S_f, S_b


def trunk_layer(x, cvec, lp, ctx):
    is_ctx = ctx is None
    Bn, T, _ = x.shape
    sh1, sc1, g1, sh2, sc2, g2, sh3, sc3, g3 = adaln(cvec, lp['w_mod'], lp['b_mod'])

    h = rmsnorm(x, lp['norm_g'][0]) * (1.0 + sc1) + sh1
    x = x + 0.5 * g1 * swiglu(h, lp['ffn_w_in'][0], lp['ffn_w_out'][0])

    h = rmsnorm(x, lp['norm_g'][1]) * (1.0 + sc2) + sh2
    xa, ga, qb, kb, vb, qc, kc, vc, qd, kd, vd, gd = split_columns(h @ lp['w_in'])

    h0 = jnp.zeros((Bn, 2, LRU_W), f32) if is_ctx else ctx['lru']
    y_a, h_fwd, h_bwd = rglru_mixer(xa, ga, lp['conv_w'], lp['conv_b'], lp['lru_w_r'], lp['lru_b_r'],
                                    lp['lru_w_i'], lp['lru_b_i'], lp['lru_lambda'], h0)
    qb = rmsnorm(heads(qb, GQA_HEADS), lp['gqa_qn'])
    kb = rmsnorm(heads(kb, GQA_KV), lp['gqa_kn'])
    vb = heads(vb, GQA_KV)
    qc = rmsnorm(heads(qc, NAT_HEADS), lp['nat_qn'])
    kc = rmsnorm(heads(kc, NAT_HEADS), lp['nat_kn'])
    vc = heads(vc, NAT_HEADS)
    if is_ctx:
        y_b = gqa_attend(qb, kb, vb)
        y_c = gqa_attend(qc, kc, vc)
        S0 = jnp.zeros((Bn, 2, RET_HEADS, HEAD_DIM, HEAD_DIM), f32)
    else:
        cos, sin = axial_rope(T)
        k_all = jnp.concatenate([apply_rope(kb, cos, sin), ctx['bk']], axis=1)
        v_all = jnp.concatenate([vb, ctx['bv']], axis=1)
        y_b = gqa_attend(apply_rope(qb, cos, sin), k_all, v_all)
        y_c = neighbourhood_attend(qc, kc, vc, ctx['ck'], ctx['cv'], lp['nat_bias'])
        S0 = ctx['ret']
    y_d, S_f, S_b = retention_mixer(qd, kd, vd, gd, lp['ret_decay'], lp['ret_gn'], S0)

    y = jnp.concatenate([y_a, y_b, y_c, y_d], axis=-1) @ lp['w_out']
    x = x + g2 * y

    h = rmsnorm(x, lp['norm_g'][2]) * (1.0 + sc3) + sh3
    x = x + 0.5 * g3 * swiglu(h, lp['ffn_w_in'][1], lp['ffn_w_out'][1])

    if not is_ctx:
        return x, None
    dt = x.dtype
    new = (kb, vb, kc, vc,
           jnp.stack([h_fwd, h_bwd], axis=1).astype(dt),
           jnp.stack([S_f, S_b], axis=1).astype(dt))
    return x, new


def setup_inputs(seed: int = 0) -> dict:
    key = jax.random.key(seed)
    ks = jax.random.split(key, 40)
    nrm = jax.random.normal
    D = D_MODEL
    bw = LRU_W // LRU_BLOCKS
    u = jax.random.uniform(ks[20], (DEPTH, 2, LRU_W), minval=0.9, maxval=0.999)
    s = u ** (1.0 / LRU_C)
    lru_lambda = jnp.log(s) - jnp.log1p(-s)
    gam_logit = jnp.log(2.0 ** (5.0 + jnp.arange(RET_HEADS, dtype=f32)) - 1.0)
    ret_decay = gam_logit[None, None, :] + 0.05 * nrm(ks[21], (DEPTH, 2, RET_HEADS))
    return {
        'x_prompt': nrm(ks[0], (BATCH, SEQ, D)),
        'x_sample': nrm(ks[1], (DEC_BATCH, DEC_SEQ, D)),
        'cache_b_k': nrm(ks[2], (DEC_BATCH, DEPTH, PAST_LEN, GQA_KV, HEAD_DIM)),
        'cache_b_v': nrm(ks[3], (DEC_BATCH, DEPTH, PAST_LEN, GQA_KV, HEAD_DIM)),
        'cache_c_k': nrm(ks[4], (DEC_BATCH, DEPTH, PAST_LEN, NAT_HEADS, HEAD_DIM)),
        'cache_c_v': nrm(ks[5], (DEC_BATCH, DEPTH, PAST_LEN, NAT_HEADS, HEAD_DIM)),
        'state_lru': 0.5 * nrm(ks[6], (DEC_BATCH, DEPTH, 2, LRU_W)),
        'state_ret': 0.1 * nrm(ks[7], (DEC_BATCH, DEPTH, 2, RET_HEADS, HEAD_DIM, HEAD_DIM)),
        'c': nrm(ks[8], (DEC_BATCH, D)),
        'c_ctx': nrm(ks[9], (D,)),
        'w_mod': 0.5 * nrm(ks[10], (DEPTH, D, N_MOD * D)) * D ** -0.5,
        'b_mod': 0.01 * nrm(ks[11], (DEPTH, N_MOD * D)),
        'norm_g': 1.0 + 0.01 * nrm(ks[12], (DEPTH, 3, D)),
        'ffn_w_in': nrm(ks[13], (DEPTH, 2, D, 2 * D_FF)) * D ** -0.5,
        'ffn_w_out': nrm(ks[14], (DEPTH, 2, D_FF, D)) * D_FF ** -0.5,
        'w_in': nrm(ks[15], (DEPTH, D, IN_COLS)) * D ** -0.5,
        'w_out': nrm(ks[16], (DEPTH, MIX_W, D)) * MIX_W ** -0.5,
        'conv_w': nrm(ks[17], (DEPTH, CONV_W, LRU_W)) * CONV_W ** -0.5,
        'conv_b': 0.01 * nrm(ks[18], (DEPTH, LRU_W)),
        'lru_w_r': nrm(ks[19], (DEPTH, 2, LRU_BLOCKS, bw, bw)) * bw ** -0.5,
        'lru_b_r': 0.01 * nrm(ks[22], (DEPTH, 2, LRU_W)),
        'lru_w_i': nrm(ks[23], (DEPTH, 2, LRU_BLOCKS, bw, bw)) * bw ** -0.5,
        'lru_b_i': 0.01 * nrm(ks[24], (DEPTH, 2, LRU_W)),
        'lru_lambda': lru_lambda,
        'gqa_qn': 1.0 + 0.01 * nrm(ks[25], (DEPTH, HEAD_DIM)),
        'gqa_kn': 1.0 + 0.01 * nrm(ks[26], (DEPTH, HEAD_DIM)),
        'nat_qn': 1.0 + 0.01 * nrm(ks[27], (DEPTH, HEAD_DIM)),
        'nat_kn': 1.0 + 0.01 * nrm(ks[28], (DEPTH, HEAD_DIM)),
        'nat_bias': 0.1 * nrm(ks[29], (DEPTH, NAT_HEADS, 2 * NAT_WR - 1, 2 * NAT_WC - 1)),
        'ret_decay': ret_decay,
        'ret_gn': 1.0 + 0.01 * nrm(ks[30], (DEPTH, RET_HEADS * HEAD_DIM)),
    }


def reference(x_prompt, x_sample, cache_b_k, cache_b_v, cache_c_k, cache_c_v, state_lru, state_ret,
              c, c_ctx, w_mod, b_mod, norm_g, ffn_w_in, ffn_w_out, w_in, w_out, conv_w, conv_b,
              lru_w_r, lru_b_r, lru_w_i, lru_b_i, lru_lambda, gqa_qn, gqa_kn, nat_qn, nat_kn,
              nat_bias, ret_decay, ret_gn):
    y_prompt = x_prompt
    y_sample = x_sample
    c_context = c_ctx[None, :]
    bk_l, bv_l, ck_l, cv_l, lru_l, ret_l = [], [], [], [], [], []
    for l in range(DEPTH):
        lp = dict(w_mod=w_mod[l], b_mod=b_mod[l], norm_g=norm_g[l], ffn_w_in=ffn_w_in[l],
                  ffn_w_out=ffn_w_out[l], w_in=w_in[l], w_out=w_out[l], conv_w=conv_w[l],
                  conv_b=conv_b[l], lru_w_r=lru_w_r[l], lru_b_r=lru_b_r[l], lru_w_i=lru_w_i[l],
                  lru_b_i=lru_b_i[l], lru_lambda=lru_lambda[l], gqa_qn=gqa_qn[l], gqa_kn=gqa_kn[l],
                  nat_qn=nat_qn[l], nat_kn=nat_kn[l], nat_bias=nat_bias[l], ret_decay=ret_decay[l],
                  ret_gn=ret_gn[l])
        y_prompt, (bk, bv, ck, cv, hl, sr) = trunk_layer(y_prompt, c_context, lp, None)
        bk_l.append(bk); bv_l.append(bv); ck_l.append(ck); cv_l.append(cv)
        lru_l.append(hl); ret_l.append(sr)
        ctx = dict(bk=cache_b_k[:, l], bv=cache_b_v[:, l], ck=cache_c_k[:, l], cv=cache_c_v[:, l],
                   lru=state_lru[:, l], ret=state_ret[:, l])
        y_sample, _ = trunk_layer(y_sample, c, lp, ctx)
    new_cache_b_k = jnp.stack(bk_l, axis=1)
    new_cache_b_v = jnp.stack(bv_l, axis=1)
    new_cache_c_k = jnp.stack(ck_l, axis=1)
    new_cache_c_v = jnp.stack(cv_l, axis=1)
    new_state_lru = jnp.stack(lru_l, axis=1)
    new_state_ret = jnp.stack(ret_l, axis=1)
    return (y_prompt, y_sample, new_cache_b_k, new_cache_b_v, new_cache_c_k, new_cache_c_v,
            new_state_lru, new_state_ret)
```

```cpp
#include <hip/hip_runtime.h>
#include <hip/hip_cooperative_groups.h>
#include <cstdio>
namespace cg = cooperative_groups;

#define LAS __attribute__((address_space(3)))
typedef unsigned short bf16_t;
typedef short bf16x8 __attribute__((ext_vector_type(8)));
typedef short bf16x4 __attribute__((ext_vector_type(4)));
typedef float f32x4 __attribute__((ext_vector_type(4)));
typedef unsigned u32x4 __attribute__((ext_vector_type(4)));
typedef unsigned u32x2 __attribute__((ext_vector_type(2)));

constexpr int M_TOK = 12288, M_P = 8192, DM = 1024, DFF = 2816, NPROJ = 2816, NMOD = 9216;
constexpr int LDS_BYTES = 139264;
constexpr size_t OFF_Y = 0, OFF_BK = 12582912, OFF_BV = OFF_BK + 4194304, OFF_CK = OFF_BV + 4194304, OFF_CV = OFF_CK + 8388608,
                 OFF_LRU = OFF_CV + 8388608, OFF_RET = OFF_LRU + 65536;

struct P {
    const float *x_prompt, *x_sample, *cbk, *cbv, *cck, *ccv, *st_lru, *st_ret, *c, *c_ctx, *w_mod, *b_mod, *norm_g, *ffn_w_in, *ffn_w_out,
        *w_in, *w_out, *conv_w, *conv_b, *lru_w_r, *lru_b_r, *lru_w_i, *lru_b_i, *lru_lambda, *gqa_qn, *gqa_kn, *nat_qn, *nat_kn, *nat_bias,
        *ret_decay, *ret_gn;
    float* out;
    bf16_t *wt_ffn_in, *wt_ffn_out, *wt_in, *wt_out, *lruWt;
    float* mod; float2* rope;
    bf16_t *h, *act, *ycat; float *proj, *hf;
};

__device__ __forceinline__ unsigned cvt_pk_bf16(float lo, float hi) { unsigned r; asm volatile("v_cvt_pk_bf16_f32 %0, %1, %2" : "=v"(r) : "v"(lo), "v"(hi)); return r; }
__device__ __forceinline__ bf16_t f2bf(float f) { return (bf16_t)(cvt_pk_bf16(f, 0.f) & 0xffffu); }
__device__ __forceinline__ float fexp2(float x) { return __builtin_amdgcn_exp2f(x); }
__device__ __forceinline__ float sigmoidf_(float x) { return 1.f / (1.f + __expf(-x)); }
__device__ __forceinline__ float siluf_(float x) { return x / (1.f + __expf(-x)); }
__device__ __forceinline__ int opaque_tid() { int t = threadIdx.x; asm volatile("" : "+v"(t)); return t; }
#define MFMA16(a, b, c) __builtin_amdgcn_mfma_f32_16x16x32_bf16((a), (b), (c), 0, 0, 0)

namespace pg8 {
constexpr int BM = 256, BK = 64, HALF = 128, HTB = HALF * BK * 2, STAGE_BYTES = 8 * HTB, NXCD = 8, WGM = 8;
__device__ __forceinline__ int lds_byte(int r, int c) { const int st = (r >> 4) * 2 + (c >> 5), rr = r & 15, cc = c & 31, ob = rr * 64 + cc * 2; return st * 1024 + (ob ^ (((ob >> 9) & 1) << 5)); }
__device__ __forceinline__ void stage_rc(int b, int& R, int& C) { const int st = b / 1024, sb = b % 1024, swz = sb ^ (((sb >> 9) & 1) << 5); R = (st >> 1) * 16 + swz / 64; C = (st & 1) * 32 + (swz % 64) / 2; }
__device__ __forceinline__ int perm32(int rho) { const int n = rho >> 4, i = rho & 15; return 8 * (i >> 2) + 4 * n + (i & 3); }
struct Unit { int pm, pn; };
struct Gemm { const bf16_t* A; const bf16_t* Bt; int M, N, K; };
struct StaticOrder {
    int nM, nN, nwg, G, c;
    __device__ void init(int M, int N, int G_, int c_) { nM = M / BM; nN = N / BM; nwg = nM * nN; G = G_; c = c_; }
    __device__ bool next(int i, Unit& u) const {
        const long L = (long)i * G + c; if (L >= nwg) return false;
        int wgid = (int)L; { const int q = nwg / NXCD, r = nwg % NXCD, xcd = wgid % NXCD, off = wgid / NXCD; wgid = (xcd < r ? xcd * (q + 1) : r * (q + 1) + (xcd - r) * q) + off; }
        const int nig = WGM * nN, gid = wgid / nig, fm = gid * WGM, gsz = (nM - fm) < WGM ? (nM - fm) : WGM;
        u.pm = fm + ((wgid % nig) % gsz); u.pn = (wgid % nig) / gsz; return true;
    }
};

template <class Epi, class Sched>
__device__ __forceinline__ void gemm_phase(LAS unsigned char* lds, const Gemm g, const Sched& S, const Epi& E) {
    const int tid = opaque_tid(), wid = __builtin_amdgcn_readfirstlane(tid >> 6), lane = tid & 63, wr = wid >> 2, wc = wid & 3, fr = lane & 15, fq = lane >> 4;
    const int K = g.K, nt = K / BK;
    unsigned voffA[2], voffB[2];
#pragma unroll
    for (int i = 0; i < 2; ++i) { int R, C; stage_rc(tid * 16 + i * 8192, R, C); const int Rb = Epi::PERM ? ((R & ~31) + perm32(R & 31)) : R;
        voffA[i] = (unsigned)(R * K + C) * 2u; voffB[i] = (unsigned)(Rb * K + C) * 2u; }
    const size_t kstep = (size_t)(BK * 2);
    const size_t hstep = (size_t)HALF * K * 2;
    const size_t tstep = 2 * hstep;
    const unsigned ldsw = (unsigned)wid * 1024u;
    const int aoff = lds_byte(wr * 64 + fr, fq * 8), boff = lds_byte(wc * 32 + fr, fq * 8);
#define PG8_SA(b, h) (((b) * 2 + (h)) * HTB)
#define PG8_SB(b, h) ((4 + (b) * 2 + (h)) * HTB)
#define PG8_STAGE(bufoff, gbase, voff) do { _Pragma("unroll") for (int _i = 0; _i < 2; ++_i) \
        __builtin_amdgcn_global_load_lds((const unsigned*)((const char*)(gbase) + (voff)[_i]), (LAS unsigned*)(lds + (bufoff) + ldsw + _i * 8192), 16, 0, 0); } while (0)
#define PG8_LDA(dst, b, h) do { _Pragma("unroll") for (int m = 0; m < 4; ++m) _Pragma("unroll") for (int k = 0; k < 2; ++k) dst[m][k] = *(const LAS bf16x8*)(lds + PG8_SA(b, h) + aoff + m * 2048 + k * 1024); } while (0)
#define PG8_LDB(dst, b, h) do { _Pragma("unroll") for (int n = 0; n < 2; ++n) _Pragma("unroll") for (int k = 0; k < 2; ++k) dst[n][k] = *(const LAS bf16x8*)(lds + PG8_SB(b, h) + boff + n * 2048 + k * 1024); } while (0)
#define PG8_MMA(ai, bj, At, Bt) do { __builtin_amdgcn_s_setprio(1); _Pragma("unroll") for (int m = 0; m < 4; ++m) _Pragma("unroll") for (int n = 0; n < 2; ++n) _Pragma("unroll") for (int k = 0; k < 2; ++k) \
        acc[ai][bj][m][n] = __builtin_amdgcn_mfma_f32_16x16x32_bf16(Bt[n][k], At[m][k], acc[ai][bj][m][n], 0, 0, 0); __builtin_amdgcn_s_setprio(0); } while (0)
#define PG8_WAIT_V(n) asm volatile("s_waitcnt vmcnt(" #n ")" ::: "memory")
#define PG8_WAIT_L(n) asm volatile("s_waitcnt lgkmcnt(" #n ")" ::: "memory")
#define PG8_BAR __builtin_amdgcn_s_barrier()
#define PG8_SCHED __builtin_amdgcn_sched_barrier(0)
    Unit cur, nxt; int ui = 0;
    if (!S.next(0, cur)) return;
    f32x4 acc[2][2][4][2];
#pragma unroll
    for (int a = 0; a < 2; ++a)
#pragma unroll
        for (int b = 0; b < 2; ++b)
#pragma unroll
            for (int m = 0; m < 4; ++m)
#pragma unroll
                for (int n = 0; n < 2; ++n) acc[a][b][m][n] = (f32x4){0.f, 0.f, 0.f, 0.f};
    bf16x8 At[4][2], B0[2][2], B1[2][2];
    const char* cA = (const char*)g.A + (size_t)cur.pm * tstep; const char* cB = (const char*)g.Bt + (size_t)cur.pn * tstep;
    PG8_STAGE(PG8_SB(0, 0), cB, voffB); PG8_STAGE(PG8_SA(0, 0), cA, voffA); PG8_STAGE(PG8_SB(0, 1), cB + hstep, voffB); PG8_STAGE(PG8_SA(0, 1), cA + hstep, voffA);
    if (wr == 1) PG8_BAR;
    PG8_WAIT_V(4); PG8_BAR;
    PG8_STAGE(PG8_SB(1, 0), cB + kstep, voffB); PG8_STAGE(PG8_SA(1, 0), cA + kstep, voffA); PG8_STAGE(PG8_SB(1, 1), cB + hstep + kstep, voffB);
    PG8_WAIT_V(6); PG8_BAR;
    for (;;) {
        const bool has_next = S.next(ui + 1, nxt);
        const char* nA = has_next ? (const char*)g.A + (size_t)nxt.pm * tstep : cA; const char* nB = has_next ? (const char*)g.Bt + (size_t)nxt.pn * tstep : cB;
        for (int t = 0; t < nt; t += 2) {
            const bool last = (t == nt - 2);
            const char* a1 = cA + (size_t)(t + 1) * kstep;
            const char* a2 = last ? nA : cA + (size_t)(t + 2) * kstep; const char* b2 = last ? nB : cB + (size_t)(t + 2) * kstep;
            const char* a3 = a2 + kstep; const char* b3 = b2 + kstep;
            PG8_LDB(B0, 0, 0); PG8_SCHED; PG8_LDA(At, 0, 0); PG8_STAGE(PG8_SA(1, 1), a1 + hstep, voffA);
            PG8_WAIT_L(8); PG8_BAR; PG8_WAIT_L(0); PG8_MMA(0, 0, At, B0); PG8_BAR; PG8_SCHED;
            PG8_LDB(B1, 0, 1); PG8_STAGE(PG8_SB(0, 0), b2, voffB);
            PG8_BAR; PG8_WAIT_L(0); PG8_MMA(0, 1, At, B1); PG8_BAR;
            PG8_LDA(At, 0, 1); PG8_STAGE(PG8_SA(0, 0), a2, voffA);
            PG8_BAR; PG8_WAIT_L(0); PG8_MMA(1, 0, At, B0); PG8_BAR; PG8_SCHED;
            PG8_STAGE(PG8_SB(0, 1), b2 + hstep, voffB);
            PG8_WAIT_V(6); PG8_BAR; PG8_MMA(1, 1, At, B1); PG8_BAR;
            PG8_LDB(B0, 1, 0); PG8_SCHED; PG8_LDA(At, 1, 0); PG8_STAGE(PG8_SA(0, 1), a2 + hstep, voffA);
            PG8_WAIT_L(8); PG8_BAR; PG8_WAIT_L(0); PG8_MMA(0, 0, At, B0); PG8_BAR; PG8_SCHED;
            PG8_LDB(B1, 1, 1); PG8_STAGE(PG8_SB(1, 0), b3, voffB);
            PG8_BAR; PG8_WAIT_L(0); PG8_MMA(0, 1, At, B1); PG8_BAR;
            PG8_LDA(At, 1, 1); PG8_STAGE(PG8_SA(1, 0), a3, voffA);
            PG8_BAR; PG8_WAIT_L(0); PG8_MMA(1, 0, At, B0); PG8_BAR; PG8_SCHED;
            PG8_STAGE(PG8_SB(1, 1), b3 + hstep, voffB);
            PG8_WAIT_V(6); PG8_BAR; PG8_MMA(1, 1, At, B1); PG8_BAR;
        }
        E(acc, cur, wr, wc, fr, fq);
        if (!has_next) break;
#pragma unroll
        for (int a = 0; a < 2; ++a)
#pragma unroll
            for (int b = 0; b < 2; ++b)
#pragma unroll
                for (int m = 0; m < 4; ++m)
#pragma unroll
                    for (int n = 0; n < 2; ++n) acc[a][b][m][n] = (f32x4){0.f, 0.f, 0.f, 0.f};
        cur = nxt; cA = nA; cB = nB; ++ui;
    }
    PG8_WAIT_V(0);
    if (wr == 0) PG8_BAR;
    PG8_BAR;
#undef PG8_SA
#undef PG8_SB
#undef PG8_STAGE
#undef PG8_LDA
#undef PG8_LDB
#undef PG8_MMA
#undef PG8_WAIT_V
#undef PG8_WAIT_L
#undef PG8_BAR
#undef PG8_SCHED
}

struct EpiF32 {
    static constexpr bool PERM = false;
    float* C; int ldc;
    __device__ __forceinline__ void operator()(const f32x4 (&acc)[2][2][4][2], const Unit& u, int wr, int wc, int fr, int fq) const {
        const int row0 = u.pm * BM + wr * 64 + fr, col0 = u.pn * BM + wc * 32 + 4 * fq;
#pragma unroll
        for (int ai = 0; ai < 2; ++ai)
#pragma unroll
            for (int m = 0; m < 4; ++m) { float* rowp = C + (size_t)(row0 + ai * HALF + m * 16) * ldc + col0;
#pragma unroll
                for (int bj = 0; bj < 2; ++bj)
#pragma unroll
                    for (int n = 0; n < 2; ++n) *(f32x4*)(rowp + bj * HALF + n * 16) = acc[ai][bj][m][n]; }
    }
};
struct EpiSwiGLU {
    static constexpr bool PERM = true;
    bf16_t* O;
    __device__ __forceinline__ void operator()(const f32x4 (&acc)[2][2][4][2], const Unit& u, int wr, int wc, int fr, int fq) const {
        const int row0 = u.pm * BM + wr * 64 + fr, col0 = u.pn * HALF + wc * 32 + 8 * fq;
#pragma unroll
        for (int ai = 0; ai < 2; ++ai)
#pragma unroll
            for (int m = 0; m < 4; ++m) {
                bf16_t* rowp = O + (size_t)(row0 + ai * HALF + m * 16) * DFF + col0;
                const f32x4 a0 = acc[ai][0][m][0], a1 = acc[ai][0][m][1], b0 = acc[ai][1][m][0], b1 = acc[ai][1][m][1];
                u32x4 pk;
                pk[0] = cvt_pk_bf16(siluf_(a0[0]) * b0[0], siluf_(a0[1]) * b0[1]);
                pk[1] = cvt_pk_bf16(siluf_(a0[2]) * b0[2], siluf_(a0[3]) * b0[3]);
                pk[2] = cvt_pk_bf16(siluf_(a1[0]) * b1[0], siluf_(a1[1]) * b1[1]);
                pk[3] = cvt_pk_bf16(siluf_(a1[2]) * b1[2], siluf_(a1[3]) * b1[3]);
                *(u32x4*)rowp = pk;
            }
    }
};
struct EpiResid {
    static constexpr bool PERM = false;
    float* X; const float* gate; float coef;
    __device__ __forceinline__ void operator()(const f32x4 (&acc)[2][2][4][2], const Unit& u, int wr, int wc, int fr, int fq) const {
        const int row0 = u.pm * BM + wr * 64 + fr, col0 = u.pn * BM + wc * 32 + 4 * fq;
        const int midx = u.pm < 32 ? 0 : 1 + ((u.pm - 32) >> 2);
        const float* g = gate + (size_t)midx * NMOD + col0;
        f32x4 gv[2][2];
#pragma unroll
        for (int bj = 0; bj < 2; ++bj)
#pragma unroll
            for (int n = 0; n < 2; ++n) gv[bj][n] = *(const f32x4*)(g + bj * HALF + n * 16) * coef;
#pragma unroll
        for (int ai = 0; ai < 2; ++ai)
#pragma unroll
            for (int m = 0; m < 4; ++m) { float* rowp = X + (size_t)(row0 + ai * HALF + m * 16) * DM + col0;
#pragma unroll
                for (int bj = 0; bj < 2; ++bj)
#pragma unroll
                    for (int n = 0; n < 2; ++n) { f32x4 xv = *(const f32x4*)(rowp + bj * HALF + n * 16); xv += gv[bj][n] * acc[ai][bj][m][n]; *(f32x4*)(rowp + bj * HALF + n * 16) = xv; } }
    }
};
}

__device__ __forceinline__ void transpose_tile(const float* src, int N, int k0, int n0src, bf16_t* dst, int K, int n0dst, float* tile  ) {
    const int tid = opaque_tid();
    __syncthreads();
#pragma unroll
    for (int i = 0; i < 2; ++i) {
        const int kk = (tid >> 4) + 32 * i, c4 = (tid & 15) * 4;
        const f32x4 v = *(const f32x4*)(src + (size_t)(k0 + kk) * N + n0src + c4);
        tile[kk * 65 + c4 + 0] = v[0]; tile[kk * 65 + c4 + 1] = v[1]; tile[kk * 65 + c4 + 2] = v[2]; tile[kk * 65 + c4 + 3] = v[3];
    }
    __syncthreads();
    const int nn = tid >> 3, kg = tid & 7;
    u32x4 pk;
#pragma unroll
    for (int j = 0; j < 4; ++j) pk[j] = cvt_pk_bf16(tile[(kg * 8 + 2 * j) * 65 + nn], tile[(kg * 8 + 2 * j + 1) * 65 + nn]);
    *(u32x4*)(dst + (size_t)(n0dst + nn) * K + k0 + kg * 8) = pk;
}

__device__ __forceinline__ void phase0(const P& p, unsigned char* smem) {
    const int tid = opaque_tid(), G = gridDim.x, bid = blockIdx.x;
    float* tile = (float*)smem;
    float* sc = (float*)(smem + 32768);
    float* part = (float*)(smem + 65536);
    for (int i = tid; i < 5 * 1024; i += 512) { const int r = i >> 10, k = i & 1023; const float v = r == 0 ? p.c_ctx[k] : p.c[(r - 1) * 1024 + k]; sc[i] = siluf_(v); }
    __syncthreads();
    for (int it = bid; it < 576; it += G) {
        const int l = it / 144, jb = it % 144, col = tid & 63, kg = tid >> 6;
        const float* w = p.w_mod + (size_t)l * 1024 * NMOD + (size_t)(kg * 128) * NMOD + jb * 64 + col;
        float a0 = 0.f, a1 = 0.f, a2 = 0.f, a3 = 0.f, a4 = 0.f;
#pragma unroll 8
        for (int k = 0; k < 128; ++k) { const float wv = w[(size_t)k * NMOD]; const int kk = kg * 128 + k;
            a0 += sc[kk] * wv; a1 += sc[1024 + kk] * wv; a2 += sc[2048 + kk] * wv; a3 += sc[3072 + kk] * wv; a4 += sc[4096 + kk] * wv; }
        __syncthreads();
        part[(kg * 5 + 0) * 64 + col] = a0; part[(kg * 5 + 1) * 64 + col] = a1; part[(kg * 5 + 2) * 64 + col] = a2; part[(kg * 5 + 3) * 64 + col] = a3; part[(kg * 5 + 4) * 64 + col] = a4;
        __syncthreads();
        if (tid < 320) { const int r = tid >> 6, cc = tid & 63; float s = p.b_mod[l * NMOD + jb * 64 + cc];
#pragma unroll
            for (int q = 0; q < 8; ++q) s += part[(q * 5 + r) * 64 + cc];
            p.mod[((size_t)l * 5 + r) * NMOD + jb * 64 + cc] = s; }
    }
    for (int it = bid; it < 8 * 1408; it += G) {
        const int mi = it / 1408, r = it % 1408, tk = r / 88, tn = r % 88;
        const int n0dst = tn * 64, pn = n0dst >> 8, w = n0dst & 255, bj = w >> 7, i0 = w & 127, n0src = bj * DFF + pn * 128 + i0;
        transpose_tile(p.ffn_w_in + (size_t)mi * 1024 * 5632, 5632, tk * 64, n0src, p.wt_ffn_in + (size_t)mi * 5632 * 1024, 1024, n0dst, tile);
    }
    for (int it = bid; it < 8 * 704; it += G) {
        const int mi = it / 704, r = it % 704, tk = r / 16, tn = r % 16;
        transpose_tile(p.ffn_w_out + (size_t)mi * DFF * 1024, 1024, tk * 64, tn * 64, p.wt_ffn_out + (size_t)mi * 1024 * DFF, DFF, tn * 64, tile);
    }
    for (int it = bid; it < 4 * 704; it += G) {
        const int mi = it / 704, r = it % 704, tk = r / 44, tn = r % 44;
        transpose_tile(p.w_in + (size_t)mi * 1024 * NPROJ, NPROJ, tk * 64, tn * 64, p.wt_in + (size_t)mi * NPROJ * 1024, 1024, tn * 64, tile);
    }
    for (int it = bid; it < 4 * 256; it += G) {
        const int mi = it / 256, r = it % 256, tk = r / 16, tn = r % 16;
        transpose_tile(p.w_out + (size_t)mi * 1024 * 1024, 1024, tk * 64, tn * 64, p.wt_out + (size_t)mi * 1024 * 1024, 1024, tn * 64, tile);
    }
    const int gt = bid * 512 + tid, GT = G * 512;
    for (int i = gt; i < 32768; i += GT) { const int t = i >> 5, pp = i & 31, f = pp & 15;
        const float inv = powf(10000.f, -(float)f / 16.f); const float pos = pp < 16 ? (float)(t >> 6) : (float)(t & 63); const float ang = pos * inv;
        p.rope[i] = make_float2(cosf(ang), sinf(ang)); }
    for (int i = gt; i < 262144; i += GT) { const int c = i & 63, dout = (i >> 6) & 63, n = (i >> 12) & 3, g = (i >> 14) & 1, d = (i >> 15) & 1, l = i >> 16;
        const float* src = g ? p.lru_w_i : p.lru_w_r;
        p.lruWt[i] = f2bf(src[((((size_t)l * 2 + d) * 4 + n) * 64 + c) * 64 + dout]); }
    for (int i = gt; i < M_TOK * DM / 4; i += GT) { const f32x4 v = i < M_P * DM / 4 ? ((const f32x4*)p.x_prompt)[i] : ((const f32x4*)p.x_sample)[i - M_P * DM / 4]; ((f32x4*)p.out)[i] = v; }
}

__device__ __forceinline__ void norm_phase(const P& p, int l, int s) {
    const int tid = opaque_tid(), lane = tid & 63, w = tid >> 6;
    const float* ng = p.norm_g + ((size_t)l * 3 + s) * DM;
    for (int row = blockIdx.x * 8 + w; row < M_TOK; row += gridDim.x * 8) {
        const int midx = row < M_P ? 0 : 1 + ((row - M_P) >> 10);
        const float* md = p.mod + ((size_t)l * 5 + midx) * NMOD + (3 * s) * DM;
        const float* x = p.out + (size_t)row * DM;
        f32x4 v[4]; float ss = 0.f;
#pragma unroll
        for (int i = 0; i < 4; ++i) { v[i] = *(const f32x4*)(x + lane * 4 + 256 * i); ss += v[i][0] * v[i][0] + v[i][1] * v[i][1] + v[i][2] * v[i][2] + v[i][3] * v[i][3]; }
#pragma unroll
        for (int o = 1; o < 64; o <<= 1) ss += __shfl_xor(ss, o);
        const float rinv = rsqrtf(ss * (1.f / DM) + 1e-6f);
#pragma unroll
        for (int i = 0; i < 4; ++i) { const int c = lane * 4 + 256 * i;
            const f32x4 g = *(const f32x4*)(ng + c), sh = *(const f32x4*)(md + c), scl = *(const f32x4*)(md + DM + c);
            const f32x4 y = v[i] * rinv * g * (scl + 1.f) + sh;
            u32x2 pk; pk[0] = cvt_pk_bf16(y[0], y[1]); pk[1] = cvt_pk_bf16(y[2], y[3]);
            *(u32x2*)(p.h + (size_t)row * DM + c) = pk; }
    }
}

template <int MODE>
__device__ __forceinline__ void attn_item(const P& p, int l, unsigned char* smem, int b, int h, int qb) {
    constexpr bool SAMPLE = (MODE == 2 || MODE == 3 || MODE == 5);
    constexpr bool RET = (MODE >= 4);
    const int tid = opaque_tid(), lane = tid & 63, w = tid >> 6, lr = lane & 15, lg = lane >> 4;
    const int rowbase = SAMPLE ? M_P + b * 1024 : b * 256;
    int qcol, kcol, vcol, ycol; const float *qgn = nullptr, *kgn = nullptr;
    if (MODE == 0 || MODE == 2) { qcol = 512 + h * 64; kcol = 768 + (h >> 1) * 64; vcol = 896 + (h >> 1) * 64; ycol = 256 + h * 64; qgn = p.gqa_qn + l * 64; kgn = p.gqa_kn + l * 64; }
    else if (MODE == 1 || MODE == 3) { qcol = 1024 + h * 64; kcol = 1280 + h * 64; vcol = 1536 + h * 64; ycol = 512 + h * 64; qgn = p.nat_qn + l * 64; kgn = p.nat_kn + l * 64; }
    else { qcol = 1792 + h * 64; kcol = 2048 + h * 64; vcol = 2304 + h * 64; ycol = 768 + h * 64; }
    bf16_t* Ks = (bf16_t*)smem;
    bf16_t* Vt = (bf16_t*)(smem + 9216);
    float* btab = (float*)(smem + 9216 + 8704);
    const float LOG2E = 1.44269504f;
    __syncthreads();
    if (MODE == 3) { for (int i = tid; i < 465; i += 512) btab[i] = p.nat_bias[((size_t)l * 4 + h) * 465 + i] * LOG2E; }

    const int tq = qb * 128 + w * 16 + lr;
    bf16x8 qf[2];
    {
        const float* qrow = p.proj + (size_t)(rowbase + tq) * NPROJ + qcol + lg * 8;
        f32x4 q0 = *(const f32x4*)qrow, q1 = *(const f32x4*)(qrow + 4), q2 = *(const f32x4*)(qrow + 32), q3 = *(const f32x4*)(qrow + 36);
        if (!RET) {
            float ss = 0.f;
#pragma unroll
            for (int j = 0; j < 4; ++j) ss += q0[j] * q0[j] + q1[j] * q1[j] + q2[j] * q2[j] + q3[j] * q3[j];
            ss += __shfl_xor(ss, 16); ss += __shfl_xor(ss, 32);
            const float rinv = rsqrtf(ss * (1.f / 64.f) + 1e-6f);
            const float* gp = qgn + lg * 8;
            q0 = q0 * rinv * *(const f32x4*)gp; q1 = q1 * rinv * *(const f32x4*)(gp + 4); q2 = q2 * rinv * *(const f32x4*)(gp + 32); q3 = q3 * rinv * *(const f32x4*)(gp + 36);
        }
        if (MODE == 2) {
            const float2* rp = p.rope + tq * 32 + lg * 4;
            const float2 c0 = rp[0], c1 = rp[1], c2 = rp[2], c3 = rp[3], c4 = rp[16], c5 = rp[17], c6 = rp[18], c7 = rp[19];
            float a, bb;
            a = q0[0]; bb = q0[1]; q0[0] = a * c0.x - bb * c0.y; q0[1] = a * c0.y + bb * c0.x;
            a = q0[2]; bb = q0[3]; q0[2] = a * c1.x - bb * c1.y; q0[3] = a * c1.y + bb * c1.x;
            a = q1[0]; bb = q1[1]; q1[0] = a * c2.x - bb * c2.y; q1[1] = a * c2.y + bb * c2.x;
            a = q1[2]; bb = q1[3]; q1[2] = a * c3.x - bb * c3.y; q1[3] = a * c3.y + bb * c3.x;
            a = q2[0]; bb = q2[1]; q2[0] = a * c4.x - bb * c4.y; q2[1] = a * c4.y + bb * c4.x;
            a = q2[2]; bb = q2[3]; q2[2] = a * c5.x - bb * c5.y; q2[3] = a * c5.y + bb * c5.x;
            a = q3[0]; bb = q3[1]; q3[0] = a * c6.x - bb * c6.y; q3[1] = a * c6.y + bb * c6.x;
            a = q3[2]; bb = q3[3]; q3[2] = a * c7.x - bb * c7.y; q3[3] = a * c7.y + bb * c7.x;
        }
        u32x4 t0, t1;
        t0[0] = cvt_pk_bf16(q0[0], q0[1]); t0[1] = cvt_pk_bf16(q0[2], q0[3]); t0[2] = cvt_pk_bf16(q1[0], q1[1]); t0[3] = cvt_pk_bf16(q1[2], q1[3]);
        t1[0] = cvt_pk_bf16(q2[0], q2[1]); t1[1] = cvt_pk_bf16(q2[2], q2[3]); t1[2] = cvt_pk_bf16(q3[0], q3[1]); t1[3] = cvt_pk_bf16(q3[2], q3[3]);
        qf[0] = __builtin_bit_cast(bf16x8, t0); qf[1] = __builtin_bit_cast(bf16x8, t1);
    }

    int ntiles, krlo = 0;
    const int nr = 2 * qb + (w >> 2), ncq = (w & 3) * 16 + lr;
    if (MODE == 0 || MODE == 1 || MODE == 4) ntiles = 4;
    else if (MODE == 2) ntiles = 20;
    else if (MODE == 5) ntiles = 18;
    else { const int r0 = 2 * qb; krlo = min(max(r0 - 4, 0), 8); const int krhi = min(max(r0 + 1 - 4, 0), 8) + 7; ntiles = 4 + (krhi - krlo + 1); }
    float lgf = 0.f, lgb = 0.f;
    if (RET) { const float xf = p.ret_decay[(l * 2 + 0) * 4 + h], xb = p.ret_decay[(l * 2 + 1) * 4 + h];
        lgf = -log1pf(expf(-xf)) * LOG2E; lgb = -log1pf(expf(-xb)) * LOG2E; }

    f32x4 o[4];
#pragma unroll
    for (int i = 0; i < 4; ++i) o[i] = (f32x4){0.f, 0.f, 0.f, 0.f};
    float m_run = -1e30f, l_run = 0.f;
    const int skey = tid >> 3, sdg = tid & 7;

    for (int kt = 0; kt < ntiles; ++kt) {
        __syncthreads();
        {
            const float *ksrc, *vsrc; bool donorm = !RET, dorope = false, ident = false; int tk = kt * 64 + skey;
            if (MODE == 0 || MODE == 1 || MODE == 4) { ksrc = p.proj + (size_t)(rowbase + tk) * NPROJ; vsrc = ksrc + vcol + sdg * 8; ksrc += kcol + sdg * 8; }
            else if (MODE == 2) {
                if (kt < 16) { ksrc = p.proj + (size_t)(rowbase + tk) * NPROJ; vsrc = ksrc + vcol + sdg * 8; ksrc += kcol + sdg * 8; dorope = true; }
                else { const size_t off = ((((size_t)b * 4 + l) * 256 + (tk - 1024)) * 2 + (h >> 1)) * 64 + sdg * 8; ksrc = p.cbk + off; vsrc = p.cbv + off; donorm = false; }
            } else if (MODE == 3) {
                if (kt < 4) { const size_t off = ((((size_t)b * 4 + l) * 256 + tk) * 4 + h) * 64 + sdg * 8; ksrc = p.cck + off; vsrc = p.ccv + off; donorm = false; }
                else { tk = (krlo + kt - 4) * 64 + skey; ksrc = p.proj + (size_t)(rowbase + tk) * NPROJ; vsrc = ksrc + vcol + sdg * 8; ksrc += kcol + sdg * 8; }
            } else {
                if (kt < 16) { ksrc = p.proj + (size_t)(rowbase + tk) * NPROJ; vsrc = ksrc + vcol + sdg * 8; ksrc += kcol + sdg * 8; }
                else { ident = true; vsrc = p.st_ret + ((((((size_t)b * 4 + l) * 2 + (kt - 16)) * 4 + h) * 64 + skey) * 64) + sdg * 8; ksrc = vsrc; }
            }
            f32x4 k0, k1;
            const f32x4 v0 = *(const f32x4*)vsrc, v1 = *(const f32x4*)(vsrc + 4);
            if (ident) {
#pragma unroll
                for (int j = 0; j < 4; ++j) { k0[j] = (sdg * 8 + j == skey) ? 1.f : 0.f; k1[j] = (sdg * 8 + 4 + j == skey) ? 1.f : 0.f; }
            } else { k0 = *(const f32x4*)ksrc; k1 = *(const f32x4*)(ksrc + 4); }
            if (donorm) {
                float ss = 0.f;
#pragma unroll
                for (int j = 0; j < 4; ++j) ss += k0[j] * k0[j] + k1[j] * k1[j];
                ss += __shfl_xor(ss, 1); ss += __shfl_xor(ss, 2); ss += __shfl_xor(ss, 4);
                const float rinv = rsqrtf(ss * (1.f / 64.f) + 1e-6f);
                k0 = k0 * rinv * *(const f32x4*)(kgn + sdg * 8); k1 = k1 * rinv * *(const f32x4*)(kgn + sdg * 8 + 4);
            }
            if (MODE == 2 && dorope) {
                const float2* rp = p.rope + tk * 32 + sdg * 4;
                const float2 c0 = rp[0], c1 = rp[1], c2 = rp[2], c3 = rp[3];
                float a, bb;
                a = k0[0]; bb = k0[1]; k0[0] = a * c0.x - bb * c0.y; k0[1] = a * c0.y + bb * c0.x;
                a = k0[2]; bb = k0[3]; k0[2] = a * c1.x - bb * c1.y; k0[3] = a * c1.y + bb * c1.x;
                a = k1[0]; bb = k1[1]; k1[0] = a * c2.x - bb * c2.y; k1[1] = a * c2.y + bb * c2.x;
                a = k1[2]; bb = k1[3]; k1[2] = a * c3.x - bb * c3.y; k1[3] = a * c3.y + bb * c3.x;
            }
            if (MODE == 0) { if (qb == 0 && (h & 1) == 0) { const size_t off = ((((size_t)b * 4 + l) * 256 + tk) * 2 + (h >> 1)) * 64 + sdg * 8;
                *(f32x4*)(p.out + OFF_BK + off) = k0; *(f32x4*)(p.out + OFF_BK + off + 4) = k1; *(f32x4*)(p.out + OFF_BV + off) = v0; *(f32x4*)(p.out + OFF_BV + off + 4) = v1; } }
            if (MODE == 1) { if (qb == 0) { const size_t off = ((((size_t)b * 4 + l) * 256 + tk) * 4 + h) * 64 + sdg * 8;
                *(f32x4*)(p.out + OFF_CK + off) = k0; *(f32x4*)(p.out + OFF_CK + off + 4) = k1; *(f32x4*)(p.out + OFF_CV + off) = v0; *(f32x4*)(p.out + OFF_CV + off + 4) = v1; } }
            u32x4 pk; pk[0] = cvt_pk_bf16(k0[0], k0[1]); pk[1] = cvt_pk_bf16(k0[2], k0[3]); pk[2] = cvt_pk_bf16(k1[0], k1[1]); pk[3] = cvt_pk_bf16(k1[2], k1[3]);
            *(u32x4*)(Ks + skey * 72 + sdg * 8) = pk;
#pragma unroll
            for (int j = 0; j < 4; ++j) { Vt[(sdg * 8 + j) * 68 + skey] = f2bf(v0[j]); Vt[(sdg * 8 + 4 + j) * 68 + skey] = f2bf(v1[j]); }
        }
        __syncthreads();
        f32x4 s[4];
#pragma unroll
        for (int ks = 0; ks < 4; ++ks) {
            s[ks] = (f32x4){0.f, 0.f, 0.f, 0.f};
#pragma unroll
            for (int st = 0; st < 2; ++st) { const bf16x8 kf = *(const bf16x8*)(Ks + (16 * ks + lr) * 72 + lg * 8 + 32 * st); s[ks] = MFMA16(kf, qf[st], s[ks]); }
        }
        if (!RET) {
            const float SC = 0.125f * LOG2E;
            float mx = -1e30f;
#pragma unroll
            for (int ks = 0; ks < 4; ++ks)
#pragma unroll
                for (int i = 0; i < 4; ++i) {
                    float v = s[ks][i] * SC;
                    if (MODE == 3) { if (kt >= 4) {
                        const int kr = krlo + kt - 4, kc = 16 * ks + lg * 4 + i;
                        const int rs = min(max(nr - 4, 0), 8), cs = min(max(ncq - 8, 0), 48);
                        const bool valid = (kr >= rs) && (kr < rs + 8) && (kc >= cs) && (kc < cs + 16);
                        const int bi = valid ? (kr - nr + 7) * 31 + (kc - ncq + 15) : 0;
                        v = valid ? v + btab[bi] : -1e30f; } }
                    s[ks][i] = v; mx = fmaxf(mx, v);
                }
            mx = fmaxf(mx, __shfl_xor(mx, 16)); mx = fmaxf(mx, __shfl_xor(mx, 32));
            const float mnew = fmaxf(m_run, mx), alpha = fexp2(m_run - mnew);
            m_run = mnew; l_run *= alpha;
#pragma unroll
            for (int dt = 0; dt < 4; ++dt) o[dt] *= alpha;
#pragma unroll
            for (int ks = 0; ks < 4; ++ks)
#pragma unroll
                for (int i = 0; i < 4; ++i) { const float pv = fexp2(s[ks][i] - mnew); l_run += pv; s[ks][i] = pv; }
        } else {
            if (MODE == 5 && kt >= 16) {
                const float scl = kt == 16 ? fexp2((float)(tq + 1) * lgf) : fexp2((float)(1024 - tq) * lgb);
#pragma unroll
                for (int ks = 0; ks < 4; ++ks) s[ks] *= scl;
            } else {
#pragma unroll
                for (int ks = 0; ks < 4; ++ks)
#pragma unroll
                    for (int i = 0; i < 4; ++i) { const int ts = kt * 64 + 16 * ks + lg * 4 + i; const int df = tq - ts;
                        const float dec = df > 0 ? fexp2((float)df * lgf) : (df < 0 ? fexp2((float)(-df) * lgb) : 2.f);
                        s[ks][i] *= 0.125f * dec; }
            }
        }
#pragma unroll
        for (int kp = 0; kp < 2; ++kp) {
            u32x4 pk; pk[0] = cvt_pk_bf16(s[2 * kp][0], s[2 * kp][1]); pk[1] = cvt_pk_bf16(s[2 * kp][2], s[2 * kp][3]);
            pk[2] = cvt_pk_bf16(s[2 * kp + 1][0], s[2 * kp + 1][1]); pk[3] = cvt_pk_bf16(s[2 * kp + 1][2], s[2 * kp + 1][3]);
            const bf16x8 pf = __builtin_bit_cast(bf16x8, pk);
#pragma unroll
            for (int dt = 0; dt < 4; ++dt) {
                const bf16_t* vp = Vt + (16 * dt + lr) * 68 + 32 * kp + lg * 4;
                const u32x2 lo = *(const u32x2*)vp, hi = *(const u32x2*)(vp + 16);
                u32x4 vv; vv[0] = lo[0]; vv[1] = lo[1]; vv[2] = hi[0]; vv[3] = hi[1];
                o[dt] = MFMA16(__builtin_bit_cast(bf16x8, vv), pf, o[dt]);
            }
        }
    }
    bf16_t* yrow = p.ycat + (size_t)(rowbase + tq) * DM + ycol + lg * 4;
    if (!RET) {
        l_run += __shfl_xor(l_run, 16); l_run += __shfl_xor(l_run, 32);
        const float inv = 1.f / l_run;
#pragma unroll
        for (int dt = 0; dt < 4; ++dt) { u32x2 pk; pk[0] = cvt_pk_bf16(o[dt][0] * inv, o[dt][1] * inv); pk[1] = cvt_pk_bf16(o[dt][2] * inv, o[dt][3] * inv); *(u32x2*)(yrow + 16 * dt) = pk; }
    } else {
        float sm = 0.f;
#pragma unroll
        for (int dt = 0; dt < 4; ++dt) sm += o[dt][0] + o[dt][1] + o[dt][2] + o[dt][3];
        sm += __shfl_xor(sm, 16); sm += __shfl_xor(sm, 32);
        const float mu = sm * (1.f / 64.f);
        float vs = 0.f;
#pragma unroll
        for (int dt = 0; dt < 4; ++dt)
#pragma unroll
            for (int i = 0; i < 4; ++i) { const float dlt = o[dt][i] - mu; vs += dlt * dlt; }
        vs += __shfl_xor(vs, 16); vs += __shfl_xor(vs, 32);
        const float rstd = rsqrtf(vs * (1.f / 64.f) + 1e-6f);
        const float* gdp = p.proj + (size_t)(rowbase + tq) * NPROJ + 2560 + h * 64 + lg * 4;
        const float* gnp = p.ret_gn + l * 256 + h * 64 + lg * 4;
#pragma unroll
        for (int dt = 0; dt < 4; ++dt) {
            const f32x4 gd = *(const f32x4*)(gdp + 16 * dt), gn = *(const f32x4*)(gnp + 16 * dt);
            float y[4];
#pragma unroll
            for (int i = 0; i < 4; ++i) y[i] = (o[dt][i] - mu) * rstd * gn[i] * siluf_(gd[i]);
            u32x2 pk; pk[0] = cvt_pk_bf16(y[0], y[1]); pk[1] = cvt_pk_bf16(y[2], y[3]); *(u32x2*)(yrow + 16 * dt) = pk;
        }
    }
}

__device__ __forceinline__ void ret_state_item(const P& p, int l, unsigned char* smem, int b, int h) {
    const int tid = opaque_tid();
    float* Kl = (float*)smem; float* Vl = Kl + 16384; float* wf = Vl + 16384; float* wb = wf + 256;
    __syncthreads();
    const float LOG2E = 1.44269504f;
    const float lgf = -log1pf(expf(-p.ret_decay[(l * 2 + 0) * 4 + h])) * LOG2E, lgb = -log1pf(expf(-p.ret_decay[(l * 2 + 1) * 4 + h])) * LOG2E;
    if (tid < 256) { wf[tid] = 0.125f * fexp2((float)(255 - tid) * lgf); wb[tid] = 0.125f * fexp2((float)tid * lgb); }
#pragma unroll
    for (int i = 0; i < 8; ++i) { const int e = tid + 512 * i, s = e >> 4, c4 = (e & 15) * 4;
        const float* row = p.proj + (size_t)(b * 256 + s) * NPROJ + h * 64 + c4;
        *(f32x4*)(Kl + s * 64 + c4) = *(const f32x4*)(row + 2048); *(f32x4*)(Vl + s * 64 + c4) = *(const f32x4*)(row + 2304); }
    __syncthreads();
    const int e = tid & 63, dg = tid >> 6;
    f32x4 af0 = {0.f, 0.f, 0.f, 0.f}, af1 = af0, ab0 = af0, ab1 = af0;
    for (int s = 0; s < 256; ++s) {
        const float v = Vl[s * 64 + e], vf = v * wf[s], vb = v * wb[s];
        const f32x4 k0 = *(const f32x4*)(Kl + s * 64 + dg * 8), k1 = *(const f32x4*)(Kl + s * 64 + dg * 8 + 4);
        af0 += k0 * vf; af1 += k1 * vf; ab0 += k0 * vb; ab1 += k1 * vb;
    }
    float* of = p.out + OFF_RET + ((((size_t)b * 4 + l) * 2 + 0) * 4 + h) * 4096 + (dg * 8) * 64 + e;
    float* ob = p.out + OFF_RET + ((((size_t)b * 4 + l) * 2 + 1) * 4 + h) * 4096 + (dg * 8) * 64 + e;
#pragma unroll
    for (int j = 0; j < 4; ++j) { of[j * 64] = af0[j]; of[(4 + j) * 64] = af1[j]; ob[j * 64] = ab0[j]; ob[(4 + j) * 64] = ab1[j]; }
}

__device__ __forceinline__ void lru_item(const P& p, int l, unsigned char* smem, int bg, int n) {
    const int tid = opaque_tid(), lane = tid & 63, w = tid >> 6, lr = lane & 15, lg = lane >> 4;
    const bool sample = bg >= 32;
    const int T = sample ? 1024 : 256, rowbase = sample ? M_P + (bg - 32) * 1024 : bg * 256, nch = T >> 7;
    bf16_t* Wt = (bf16_t*)smem;
    bf16_t* xcb = (bf16_t*)(smem + 18432);
    float* uL = (float*)(smem + 36864);
    float* aL = (float*)(smem + 71680);
    float* segA = (float*)(smem + 106496);
    float* segB = segA + 512;
    const int ch = lane;
    const int c4 = (tid & 15) * 4;
    f32x4 cw0 = *(const f32x4*)(p.conv_w + ((size_t)l * 4 + 0) * 256 + n * 64 + c4), cw1 = *(const f32x4*)(p.conv_w + ((size_t)l * 4 + 1) * 256 + n * 64 + c4),
          cw2 = *(const f32x4*)(p.conv_w + ((size_t)l * 4 + 2) * 256 + n * 64 + c4), cw3 = *(const f32x4*)(p.conv_w + ((size_t)l * 4 + 3) * 256 + n * 64 + c4),
          cbv = *(const f32x4*)(p.conv_b + (size_t)l * 256 + n * 64 + c4);
    for (int d = 0; d < 2; ++d) {
        __syncthreads();
#pragma unroll
        for (int i = 0; i < 2; ++i) { const u32x4 v = *(const u32x4*)(p.lruWt + ((((size_t)l * 2 + d) * 2 + i) * 4 + n) * 4096 + tid * 8);
            *(u32x4*)(Wt + (i * 64 + (tid >> 3)) * 72 + (tid & 7) * 8) = v; }
        float sp[4], br[4], bi[4];
#pragma unroll
        for (int ct = 0; ct < 4; ++ct) { const int cidx = (l * 2 + d) * 256 + n * 64 + 16 * ct + lr;
            sp[ct] = log1pf(expf(-p.lru_lambda[cidx])); br[ct] = p.lru_b_r[cidx]; bi[ct] = p.lru_b_i[cidx]; }
        float carry = sample ? p.st_lru[(((size_t)(bg - 32) * 4 + l) * 2 + d) * 256 + n * 64 + ch] : 0.f;
        for (int cc = 0; cc < nch; ++cc) {
            const int ci = d == 0 ? cc : nch - 1 - cc, t0 = ci * 128;
            __syncthreads();
#pragma unroll
            for (int k = 0; k < 4; ++k) {
                const int tt = (tid >> 4) + 32 * k, t = t0 + tt;
                const float* base = p.proj + (size_t)(rowbase + t) * NPROJ + n * 64 + c4;
                f32x4 acc = cbv;
                if (t - 2 >= 0) acc += cw0 * *(const f32x4*)(base - 2 * NPROJ);
                if (t - 1 >= 0) acc += cw1 * *(const f32x4*)(base - NPROJ);
                acc += cw2 * *(const f32x4*)base;
                if (t + 1 < T) acc += cw3 * *(const f32x4*)(base + NPROJ);
                *(f32x4*)(uL + tt * 68 + c4) = acc;
                u32x2 pk; pk[0] = cvt_pk_bf16(acc[0], acc[1]); pk[1] = cvt_pk_bf16(acc[2], acc[3]);
                *(u32x2*)(xcb + tt * 72 + c4) = pk;
            }
            __syncthreads();
            f32x4 acc[2][4];
#pragma unroll
            for (int g = 0; g < 2; ++g)
#pragma unroll
                for (int ct = 0; ct < 4; ++ct) acc[g][ct] = (f32x4){0.f, 0.f, 0.f, 0.f};
#pragma unroll
            for (int st = 0; st < 2; ++st) {
                const bf16x8 af = *(const bf16x8*)(xcb + (16 * w + lr) * 72 + lg * 8 + 32 * st);
#pragma unroll
                for (int g = 0; g < 2; ++g)
#pragma unroll
                    for (int ct = 0; ct < 4; ++ct) { const bf16x8 bf = *(const bf16x8*)(Wt + (g * 64 + 16 * ct + lr) * 72 + lg * 8 + 32 * st); acc[g][ct] = MFMA16(af, bf, acc[g][ct]); }
            }
#pragma unroll
            for (int ct = 0; ct < 4; ++ct)
#pragma unroll
                for (int i = 0; i < 4; ++i) {
                    const int tok = 16 * w + lg * 4 + i, dout = 16 * ct + lr;
                    const float r = sigmoidf_(acc[0][ct][i] + br[ct]), ig = sigmoidf_(acc[1][ct][i] + bi[ct]);
                    const float la = -8.f * r * sp[ct], a = expf(la), xc = uL[tok * 68 + dout];
                    const float u = sqrtf(-expm1f(2.f * la)) * ig * xc;
                    aL[tok * 68 + dout] = a; uL[tok * 68 + dout] = u;
                }
            __syncthreads();
            const int seg = d == 0 ? w : 7 - w;
            { float A = 1.f, Bv = 0.f;
#pragma unroll
              for (int k = 0; k < 16; ++k) { const int tok = 16 * w + (d == 0 ? k : 15 - k); const float a = aL[tok * 68 + ch], u = uL[tok * 68 + ch]; Bv = a * Bv + u; A *= a; }
              segA[seg * 64 + ch] = A; segB[seg * 64 + ch] = Bv; }
            __syncthreads();
            float hin = carry, hall = carry;
#pragma unroll
            for (int sgi = 0; sgi < 8; ++sgi) { if (sgi == seg) hin = hall; hall = segA[sgi * 64 + ch] * hall + segB[sgi * 64 + ch]; }
            carry = hall;
            float hh = hin;
#pragma unroll
            for (int k = 0; k < 16; ++k) {
                const int tok = 16 * w + (d == 0 ? k : 15 - k); const float a = aL[tok * 68 + ch], u = uL[tok * 68 + ch]; hh = a * hh + u;
                const size_t row = (size_t)(rowbase + t0 + tok);
                if (d == 0) p.hf[row * 256 + n * 64 + ch] = hh;
                else { const float hfv = p.hf[row * 256 + n * 64 + ch], ga = p.proj[row * NPROJ + 256 + n * 64 + ch];
                    const float gl = 0.5f * ga * (1.f + tanhf(0.7978845608f * (ga + 0.044715f * ga * ga * ga)));
                    p.ycat[row * DM + n * 64 + ch] = f2bf((hfv + hh) * gl); }
            }
        }
        if (!sample && w == 0) p.out[OFF_LRU + (((size_t)bg * 4 + l) * 2 + d) * 256 + n * 64 + ch] = carry;
    }
}

__device__ __forceinline__ void mixer_phase(const P& p, int l, unsigned char* smem) {
    for (int it = blockIdx.x; it < 1424; it += gridDim.x) {
        if (it < 16) lru_item(p, l, smem, 32 + (it >> 2), it & 3);
        else if (it < 144) { const int i = it - 16; attn_item<2>(p, l, smem, i >> 5, (i >> 3) & 3, i & 7); }
        else if (it < 272) { const int i = it - 144; attn_item<5>(p, l, smem, i >> 5, (i >> 3) & 3, i & 7); }
        else if (it < 400) { const int i = it - 272; attn_item<3>(p, l, smem, i >> 5, (i >> 3) & 3, i & 7); }
        else if (it < 528) { const int i = it - 400; lru_item(p, l, smem, i >> 2, i & 3); }
        else if (it < 784) { const int i = it - 528; attn_item<0>(p, l, smem, i >> 3, (i >> 1) & 3, i & 1); }
        else if (it < 1040) { const int i = it - 784; attn_item<1>(p, l, smem, i >> 3, (i >> 1) & 3, i & 1); }
        else if (it < 1296) { const int i = it - 1040; attn_item<4>(p, l, smem, i >> 3, (i >> 1) & 3, i & 1); }
        else { const int i = it - 1296; ret_state_item(p, l, smem, i >> 2, i & 3); }
    }
}

__global__ void __launch_bounds__(512, 2) mega(P p) {
    extern __shared__ __attribute__((aligned(16))) unsigned char smem[];
    cg::grid_group grid = cg::this_grid();
    LAS unsigned char* lds = (LAS unsigned char*)smem;
    phase0(p, smem);
    grid.sync();
    pg8::StaticOrder S;
    for (int l = 0; l < 4; ++l) {
        for (int s = 0; s < 3; ++s) {
            norm_phase(p, l, s);
            grid.sync();
            pg8::Gemm g2; float coef;
            if (s != 1) {
                const int sl = s >> 1;
                pg8::Gemm g{p.h, p.wt_ffn_in + ((size_t)l * 2 + sl) * 5632 * 1024, M_TOK, 5632, 1024};
                S.init(M_TOK, 5632, gridDim.x, blockIdx.x);
                pg8::gemm_phase(lds, g, S, pg8::EpiSwiGLU{p.act});
                grid.sync();
                g2 = pg8::Gemm{p.act, p.wt_ffn_out + ((size_t)l * 2 + sl) * 1024 * DFF, M_TOK, 1024, DFF}; coef = 0.5f;
            } else {
                pg8::Gemm g{p.h, p.wt_in + (size_t)l * NPROJ * 1024, M_TOK, NPROJ, 1024};
                S.init(M_TOK, NPROJ, gridDim.x, blockIdx.x);
                pg8::gemm_phase(lds, g, S, pg8::EpiF32{p.proj, NPROJ});
                grid.sync();
                mixer_phase(p, l, smem);
                grid.sync();
                g2 = pg8::Gemm{p.ycat, p.wt_out + (size_t)l * 1024 * 1024, M_TOK, 1024, 1024}; coef = 1.0f;
            }
            S.init(M_TOK, 1024, gridDim.x, blockIdx.x);
            pg8::gemm_phase(lds, g2, S, pg8::EpiResid{p.out, p.mod + (size_t)l * 5 * NMOD + (3 * s + 2) * DM, coef});
            grid.sync();
        }
    }
}

extern "C" void kernel_launch(void* const* d_in, const int* in_sizes, int n_in, void* d_out, int out_size, void* d_ws, size_t ws_size, hipStream_t stream) {
    static int grid_blocks = 0;
    if (!grid_blocks) {
        hipFuncSetAttribute((const void*)mega, hipFuncAttributeMaxDynamicSharedMemorySize, LDS_BYTES);
        int dev = 0, cus = 0, per_cu = 0;
        hipGetDevice(&dev);
        hipDeviceGetAttribute(&cus, hipDeviceAttributeMultiprocessorCount, dev);
        hipOccupancyMaxActiveBlocksPerMultiprocessor(&per_cu, mega, 512, LDS_BYTES);
        if (per_cu > 1) per_cu = 1;
        grid_blocks = cus * per_cu;
        if (grid_blocks <= 0) grid_blocks = 256;
    }
    P p{};
    const float** pf = (const float**)&p;
    for (int i = 0; i < 31; ++i) pf[i] = (const float*)d_in[i];
    p.out = (float*)d_out;
    char* ws = (char*)d_ws; size_t off = 0;
    auto carve = [&](size_t bytes) { char* r = ws + off; off += (bytes + 255) & ~(size_t)255; return r; };
    p.wt_ffn_in = (bf16_t*)carve((size_t)8 * 5632 * 1024 * 2);
    p.wt_ffn_out = (bf16_t*)carve((size_t)8 * 1024 * DFF * 2);
    p.wt_in = (bf16_t*)carve((size_t)4 * NPROJ * 1024 * 2);
    p.wt_out = (bf16_t*)carve((size_t)4 * 1024 * 1024 * 2);
    p.lruWt = (bf16_t*)carve((size_t)262144 * 2);
    p.mod = (float*)carve((size_t)4 * 5 * NMOD * 4);
    p.rope = (float2*)carve((size_t)32768 * 8);
    p.h = (bf16_t*)carve((size_t)M_TOK * DM * 2);
    p.act = (bf16_t*)carve((size_t)M_TOK * DFF * 2);
    p.ycat = (bf16_t*)carve((size_t)M_TOK * DM * 2);
    p.proj = (float*)carve((size_t)M_TOK * NPROJ * 4);
    p.hf = (float*)carve((size_t)M_TOK * 256 * 4);
    void* args[] = {&p};
    hipError_t e = hipLaunchCooperativeKernel((void*)mega, dim3(grid_blocks), dim3(512), args, LDS_BYTES, stream);
    if (e != hipSuccess) fprintf(stderr, "cooperative launch failed: %s (grid %d)\n", hipGetErrorString(e), grid_blocks);
}
```

```cpp
#include <hip/hip_runtime.h>
#include <hip/hip_cooperative_groups.h>
#include <cstdio>
namespace cg = cooperative_groups;

#define LAS __attribute__((address_space(3)))
typedef unsigned short bf16_t;
typedef short bf16x8 __attribute__((ext_vector_type(8)));
typedef short bf16x4 __attribute__((ext_vector_type(4)));
typedef float f32x4 __attribute__((ext_vector_type(4)));
typedef unsigned u32x4 __attribute__((ext_vector_type(4)));
typedef unsigned u32x2 __attribute__((ext_vector_type(2)));

constexpr int M_TOK = 12288, M_P = 8192, DM = 1024, DFF = 2816, NPROJ = 2816, NMOD = 9216;
constexpr int LDS_BYTES = 139264;
constexpr size_t OFF_Y = 0, OFF_BK = 12582912, OFF_BV = OFF_BK + 4194304, OFF_CK = OFF_BV + 4194304, OFF_CV = OFF_CK + 8388608,
                 OFF_LRU = OFF_CV + 8388608, OFF_RET = OFF_LRU + 65536;

struct P {
    const float *x_prompt, *x_sample, *cbk, *cbv, *cck, *ccv, *st_lru, *st_ret, *c, *c_ctx, *w_mod, *b_mod, *norm_g, *ffn_w_in, *ffn_w_out,
        *w_in, *w_out, *conv_w, *conv_b, *lru_w_r, *lru_b_r, *lru_w_i, *lru_b_i, *lru_lambda, *gqa_qn, *gqa_kn, *nat_qn, *nat_kn, *nat_bias,
        *ret_decay, *ret_gn;
    float* out;
    bf16_t *wt_ffn_in, *wt_ffn_out, *wt_in, *wt_out, *lruWt;
    float* mod; float2* rope;
    bf16_t *h, *act, *ycat; float *proj, *hf;
    unsigned* bar;
};

__device__ __forceinline__ unsigned cvt_pk_bf16(float lo, float hi) { unsigned r; asm volatile("v_cvt_pk_bf16_f32 %0, %1, %2" : "=v"(r) : "v"(lo), "v"(hi)); return r; }
__device__ __forceinline__ bf16_t f2bf(float f) { return (bf16_t)(cvt_pk_bf16(f, 0.f) & 0xffffu); }
__device__ __forceinline__ float fexp2(float x) { return __builtin_amdgcn_exp2f(x); }
__device__ __forceinline__ float sigmoidf_(float x) { return 1.f / (1.f + __expf(-x)); }
__device__ __forceinline__ float siluf_(float x) { return x / (1.f + __expf(-x)); }
__device__ __forceinline__ int opaque_tid() { int t = threadIdx.x; asm volatile("" : "+v"(t)); return t; }
#define MFMA16(a, b, c) __builtin_amdgcn_mfma_f32_16x16x32_bf16((a), (b), (c), 0, 0, 0)


#define XB_TMO      128
#define XB_XCNT(j)  (256  + 64 * (j))
#define XB_XSUB(j)  (1280 + 64 * (j))
#define XB_XGEN(j)  (2304 + 64 * (j))
#define XB_TOP      3328
#define XB_TOPGEN   3392
#define XCD_BAR_WORDS 3456
#define XB_SPIN_CAP (1u << 18)
__device__ __forceinline__ unsigned xb_ld(unsigned* p)              { return __hip_atomic_load(p, __ATOMIC_RELAXED, __HIP_MEMORY_SCOPE_AGENT); }
__device__ __forceinline__ unsigned xb_add(unsigned* p, unsigned v) { return __hip_atomic_fetch_add(p, v, __ATOMIC_RELAXED, __HIP_MEMORY_SCOPE_AGENT); }
__device__ __forceinline__ unsigned xb_xcc_id() { return (unsigned)__builtin_amdgcn_s_getreg((3 << 11) | 20) & 0xFu; }
#define XB_SPIN(cond, bar) do { unsigned _sp = 0; while (cond) { __builtin_amdgcn_s_sleep(1); \
    if ((++_sp & 255u) == 0u) { if (xb_ld(&(bar)[XB_TMO])) break; if (_sp > XB_SPIN_CAP) { atomicAdd(&(bar)[XB_TMO], 1u); break; } } } } while (0)
struct XcdBarrier { unsigned* bar; unsigned x; volatile LAS unsigned* st; };
__device__ __forceinline__ XcdBarrier xcd_barrier_post(unsigned* bar, volatile LAS unsigned* st) {
    XcdBarrier b; b.bar = bar; b.x = xb_xcc_id(); b.st = st;
    if (threadIdx.x == 0) (void)xb_add(&bar[XB_XCNT(b.x)], 1u);
    return b;
}
__device__ __forceinline__ void xcd_barrier_complete(unsigned* bar, unsigned x, unsigned& nloc, unsigned& nx) {
    const unsigned G = gridDim.x * gridDim.y * gridDim.z;
    unsigned sum, cnt, mine, sp = 0u;
    for (;;) {
        sum = 0u; cnt = 0u; mine = 0u;
#pragma unroll
        for (unsigned j = 0; j < 16; ++j) { const unsigned c = xb_ld(&bar[XB_XCNT(j)]); sum += c; cnt += (c > 0u) ? 1u : 0u; mine = (j == x) ? c : mine; }
        if (sum == G) break;
        __builtin_amdgcn_s_sleep(1);
        if ((++sp & 255u) == 0u) { if (xb_ld(&bar[XB_TMO])) break; if (sp > XB_SPIN_CAP) { atomicAdd(&bar[XB_TMO], 1u); break; } }
    }
    nloc = mine > 0u ? mine : 1u; nx = cnt > 0u ? cnt : 1u;
}
__device__ __forceinline__ void xcd_barrier(const XcdBarrier& b) {
    asm volatile("s_waitcnt vmcnt(0)" ::: "memory");
    __syncthreads();
    if (threadIdx.x == 0) {
        unsigned* bar = b.bar;
        __builtin_amdgcn_s_waitcnt(0);
        unsigned nloc = b.st[0], nx = b.st[1];
        if (nloc == 0u) { xcd_barrier_complete(bar, b.x, nloc, nx); b.st[0] = nloc; b.st[1] = nx; }
        const unsigned old = xb_add(&bar[XB_XSUB(b.x)], 1u);
        const unsigned gen = old / nloc;
        if (old + 1u == (gen + 1u) * nloc) {
            __builtin_amdgcn_fence(__ATOMIC_RELEASE, "agent");
            asm volatile("s_waitcnt vmcnt(0)" ::: "memory");
            const unsigned og = xb_add(&bar[XB_TOP], 1u);
            const unsigned tg = og / nx;
            if (og + 1u == (tg + 1u) * nx) xb_add(&bar[XB_TOPGEN], 1u);
            else XB_SPIN(xb_ld(&bar[XB_TOPGEN]) == tg, bar);
            __builtin_amdgcn_fence(__ATOMIC_ACQUIRE, "agent");
            xb_add(&bar[XB_XGEN(b.x)], 1u);
            asm volatile("s_waitcnt vmcnt(0)" ::: "memory");
        } else {
            XB_SPIN(xb_ld(&bar[XB_XGEN(b.x)]) == gen, bar);
            __builtin_amdgcn_fence(__ATOMIC_ACQUIRE, "agent");
            asm volatile("s_waitcnt vmcnt(0)" ::: "memory");
        }
    }
    __syncthreads();
}

namespace pg8 {
constexpr int BM = 256, BK = 64, HALF = 128, HTB = HALF * BK * 2, STAGE_BYTES = 8 * HTB, NXCD = 8, WGM = 8;
__device__ __forceinline__ int lds_byte(int r, int c) { const int st = (r >> 4) * 2 + (c >> 5), rr = r & 15, cc = c & 31, ob = rr * 64 + cc * 2; return st * 1024 + (ob ^ (((ob >> 9) & 1) << 5)); }
__device__ __forceinline__ void stage_rc(int b, int& R, int& C) { const int st = b / 1024, sb = b % 1024, swz = sb ^ (((sb >> 9) & 1) << 5); R = (st >> 1) * 16 + swz / 64; C = (st & 1) * 32 + (swz % 64) / 2; }
__device__ __forceinline__ int perm32(int rho) { const int n = rho >> 4, i = rho & 15; return 8 * (i >> 2) + 4 * n + (i & 3); }
struct Unit { int pm, pn; };
struct Gemm { const bf16_t* A; const bf16_t* Bt; int M, N, K; };
struct StaticOrder {
    int nM, nN, nwg, G, c;
    __device__ void init(int M, int N, int G_, int c_) { nM = M / BM; nN = N / BM; nwg = nM * nN; G = G_; c = c_; }
    __device__ bool next(int i, Unit& u) const {
        const long L = (long)i * G + c; if (L >= nwg) return false;
        int wgid = (int)L; { const int q = nwg / NXCD, r = nwg % NXCD, xcd = wgid % NXCD, off = wgid / NXCD; wgid = (xcd < r ? xcd * (q + 1) : r * (q + 1) + (xcd - r) * q) + off; }
        const int nig = WGM * nN, gid = wgid / nig, fm = gid * WGM, gsz = (nM - fm) < WGM ? (nM - fm) : WGM;
        u.pm = fm + ((wgid % nig) % gsz); u.pn = (wgid % nig) / gsz; return true;
    }
};

template <class Epi, class Sched>
__device__ __forceinline__ void gemm_phase(LAS unsigned char* lds, const Gemm g, const Sched& S, const Epi& E) {
    const int tid = opaque_tid(), wid = __builtin_amdgcn_readfirstlane(tid >> 6), lane = tid & 63, wr = wid >> 2, wc = wid & 3, fr = lane & 15, fq = lane >> 4;
    const int K = g.K, nt = K / BK;
    unsigned voffA[2], voffB[2];
#pragma unroll
    for (int i = 0; i < 2; ++i) { int R, C; stage_rc(tid * 16 + i * 8192, R, C); const int Rb = Epi::PERM ? ((R & ~31) + perm32(R & 31)) : R;
        voffA[i] = (unsigned)(R * K + C) * 2u; voffB[i] = (unsigned)(Rb * K + C) * 2u; }
    const size_t kstep = (size_t)(BK * 2);
    const size_t hstep = (size_t)HALF * K * 2;
    const size_t tstep = 2 * hstep;
    const unsigned ldsw = (unsigned)wid * 1024u;
    const int aoff = lds_byte(wr * 64 + fr, fq * 8), boff = lds_byte(wc * 32 + fr, fq * 8);
#define PG8_SA(b, h) (((b) * 2 + (h)) * HTB)
#define PG8_SB(b, h) ((4 + (b) * 2 + (h)) * HTB)
#define PG8_STAGE(bufoff, gbase, voff) do { _Pragma("unroll") for (int _i = 0; _i < 2; ++_i) \
        __builtin_amdgcn_global_load_lds((const unsigned*)((const char*)(gbase) + (voff)[_i]), (LAS unsigned*)(lds + (bufoff) + ldsw + _i * 8192), 16, 0, 0); } while (0)
#define PG8_LDA(dst, b, h) do { _Pragma("unroll") for (int m = 0; m < 4; ++m) _Pragma("unroll") for (int k = 0; k < 2; ++k) dst[m][k] = *(const LAS bf16x8*)(lds + PG8_SA(b, h) + aoff + m * 2048 + k * 1024); } while (0)
#define PG8_LDB(dst, b, h) do { _Pragma("unroll") for (int n = 0; n < 2; ++n) _Pragma("unroll") for (int k = 0; k < 2; ++k) dst[n][k] = *(const LAS bf16x8*)(lds + PG8_SB(b, h) + boff + n * 2048 + k * 1024); } while (0)
#define PG8_MMA(ai, bj, At, Bt) do { __builtin_amdgcn_s_setprio(1); _Pragma("unroll") for (int m = 0; m < 4; ++m) _Pragma("unroll") for (int n = 0; n < 2; ++n) _Pragma("unroll") for (int k = 0; k < 2; ++k) \
        acc[ai][bj][m][n] = __builtin_amdgcn_mfma_f32_16x16x32_bf16(Bt[n][k], At[m][k], acc[ai][bj][m][n], 0, 0, 0); __builtin_amdgcn_s_setprio(0); } while (0)
#define PG8_WAIT_V(n) asm volatile("s_waitcnt vmcnt(" #n ")" ::: "memory")
#define PG8_WAIT_L(n) asm volatile("s_waitcnt lgkmcnt(" #n ")" ::: "memory")
#define PG8_BAR __builtin_amdgcn_s_barrier()
#define PG8_SCHED __builtin_amdgcn_sched_barrier(0)
    Unit cur, nxt; int ui = 0;
    if (!S.next(0, cur)) return;
    f32x4 acc[2][2][4][2];
#pragma unroll
    for (int a = 0; a < 2; ++a)
#pragma unroll
        for (int b = 0; b < 2; ++b)
#pragma unroll
            for (int m = 0; m < 4; ++m)
#pragma unroll
                for (int n = 0; n < 2; ++n) acc[a][b][m][n] = (f32x4){0.f, 0.f, 0.f, 0.f};
    bf16x8 At[4][2], B0[2][2], B1[2][2];
    const char* cA = (const char*)g.A + (size_t)cur.pm * tstep; const char* cB = (const char*)g.Bt + (size_t)cur.pn * tstep;
    PG8_STAGE(PG8_SB(0, 0), cB, voffB); PG8_STAGE(PG8_SA(0, 0), cA, voffA); PG8_STAGE(PG8_SB(0, 1), cB + hstep, voffB); PG8_STAGE(PG8_SA(0, 1), cA + hstep, voffA);
    if (wr == 1) PG8_BAR;
    PG8_WAIT_V(4); PG8_BAR;
    PG8_STAGE(PG8_SB(1, 0), cB + kstep, voffB); PG8_STAGE(PG8_SA(1, 0), cA + kstep, voffA); PG8_STAGE(PG8_SB(1, 1), cB + hstep + kstep, voffB);
    PG8_WAIT_V(6); PG8_BAR;
    for (;;) {
        const bool has_next = S.next(ui + 1, nxt);
        const char* nA = has_next ? (const char*)g.A + (size_t)nxt.pm * tstep : cA; const char* nB = has_next ? (const char*)g.Bt + (size_t)nxt.pn * tstep : cB;
        for (int t = 0; t < nt; t += 2) {
            const bool last = (t == nt - 2);
            const char* a1 = cA + (size_t)(t + 1) * kstep;
            const char* a2 = last ? nA : cA + (size_t)(t + 2) * kstep; const char* b2 = last ? nB : cB + (size_t)(t + 2) * kstep;
            const char* a3 = a2 + kstep; const char* b3 = b2 + kstep;
            PG8_LDB(B0, 0, 0); PG8_SCHED; PG8_LDA(At, 0, 0); PG8_STAGE(PG8_SA(1, 1), a1 + hstep, voffA);
            PG8_WAIT_L(8); PG8_BAR; PG8_WAIT_L(0); PG8_MMA(0, 0, At, B0); PG8_BAR; PG8_SCHED;
            PG8_LDB(B1, 0, 1); PG8_STAGE(PG8_SB(0, 0), b2, voffB);
            PG8_BAR; PG8_WAIT_L(0); PG8_MMA(0, 1, At, B1); PG8_BAR;
            PG8_LDA(At, 0, 1); PG8_STAGE(PG8_SA(0, 0), a2, voffA);
            PG8_BAR; PG8_WAIT_L(0); PG8_MMA(1, 0, At, B0); PG8_BAR; PG8_SCHED;
            PG8_STAGE(PG8_SB(0, 1), b2 + hstep, voffB);
            PG8_WAIT_V(6); PG8_BAR; PG8_MMA(1, 1, At, B1); PG8_BAR;
            PG8_LDB(B0, 1, 0); PG8_SCHED; PG8_LDA(At, 1, 0); PG8_STAGE(PG8_SA(0, 1), a2 + hstep, voffA);
            PG8_WAIT_L(8); PG8_BAR; PG8_WAIT_L(0); PG8_MMA(0, 0, At, B0); PG8_BAR; PG8_SCHED;
            PG8_LDB(B1, 1, 1); PG8_STAGE(PG8_SB(1, 0), b3, voffB);
            PG8_BAR; PG8_WAIT_L(0); PG8_MMA(0, 1, At, B1); PG8_BAR;
            PG8_LDA(At, 1, 1); PG8_STAGE(PG8_SA(1, 0), a3, voffA);
            PG8_BAR; PG8_WAIT_L(0); PG8_MMA(1, 0, At, B0); PG8_BAR; PG8_SCHED;
            PG8_STAGE(PG8_SB(1, 1), b3 + hstep, voffB);
            PG8_WAIT_V(6); PG8_BAR; PG8_MMA(1, 1, At, B1); PG8_BAR;
        }
        E(acc, cur, wr, wc, fr, fq);
        if (!has_next) break;
#pragma unroll
        for (int a = 0; a < 2; ++a)
#pragma unroll
            for (int b = 0; b < 2; ++b)
#pragma unroll
                for (int m = 0; m < 4; ++m)
#pragma unroll
                    for (int n = 0; n < 2; ++n) acc[a][b][m][n] = (f32x4){0.f, 0.f, 0.f, 0.f};
        cur = nxt; cA = nA; cB = nB; ++ui;
    }
    PG8_WAIT_V(0);
    if (wr == 0) PG8_BAR;
    PG8_BAR;
#undef PG8_SA
#undef PG8_SB
#undef PG8_STAGE
#undef PG8_LDA
#undef PG8_LDB
#undef PG8_MMA
#undef PG8_WAIT_V
#undef PG8_WAIT_L
#undef PG8_BAR
#undef PG8_SCHED
}

struct EpiF32 {
    static constexpr bool PERM = false;
    float* C; int ldc;
    __device__ __forceinline__ void operator()(const f32x4 (&acc)[2][2][4][2], const Unit& u, int wr, int wc, int fr, int fq) const {
        const int row0 = u.pm * BM + wr * 64 + fr, col0 = u.pn * BM + wc * 32 + 4 * fq;
#pragma unroll
        for (int ai = 0; ai < 2; ++ai)
#pragma unroll
            for (int m = 0; m < 4; ++m) { float* rowp = C + (size_t)(row0 + ai * HALF + m * 16) * ldc + col0;
#pragma unroll
                for (int bj = 0; bj < 2; ++bj)
#pragma unroll
                    for (int n = 0; n < 2; ++n) *(f32x4*)(rowp + bj * HALF + n * 16) = acc[ai][bj][m][n]; }
    }
};
struct EpiSwiGLU {
    static constexpr bool PERM = true;
    bf16_t* O;
    __device__ __forceinline__ void operator()(const f32x4 (&acc)[2][2][4][2], const Unit& u, int wr, int wc, int fr, int fq) const {
        const int row0 = u.pm * BM + wr * 64 + fr, col0 = u.pn * HALF + wc * 32 + 8 * fq;
#pragma unroll
        for (int ai = 0; ai < 2; ++ai)
#pragma unroll
            for (int m = 0; m < 4; ++m) {
                bf16_t* rowp = O + (size_t)(row0 + ai * HALF + m * 16) * DFF + col0;
                const f32x4 a0 = acc[ai][0][m][0], a1 = acc[ai][0][m][1], b0 = acc[ai][1][m][0], b1 = acc[ai][1][m][1];
                u32x4 pk;
                pk[0] = cvt_pk_bf16(siluf_(a0[0]) * b0[0], siluf_(a0[1]) * b0[1]);
                pk[1] = cvt_pk_bf16(siluf_(a0[2]) * b0[2], siluf_(a0[3]) * b0[3]);
                pk[2] = cvt_pk_bf16(siluf_(a1[0]) * b1[0], siluf_(a1[1]) * b1[1]);
                pk[3] = cvt_pk_bf16(siluf_(a1[2]) * b1[2], siluf_(a1[3]) * b1[3]);
                *(u32x4*)rowp = pk;
            }
    }
};
struct EpiResid {
    static constexpr bool PERM = false;
    float* X; const float* gate; float coef;
    __device__ __forceinline__ void operator()(const f32x4 (&acc)[2][2][4][2], const Unit& u, int wr, int wc, int fr, int fq) const {
        const int row0 = u.pm * BM + wr * 64 + fr, col0 = u.pn * BM + wc * 32 + 4 * fq;
        const int midx = u.pm < 32 ? 0 : 1 + ((u.pm - 32) >> 2);
        const float* g = gate + (size_t)midx * NMOD + col0;
        f32x4 gv[2][2];
#pragma unroll
        for (int bj = 0; bj < 2; ++bj)
#pragma unroll
            for (int n = 0; n < 2; ++n) gv[bj][n] = *(const f32x4*)(g + bj * HALF + n * 16) * coef;
#pragma unroll
        for (int ai = 0; ai < 2; ++ai)
#pragma unroll
            for (int m = 0; m < 4; ++m) { float* rowp = X + (size_t)(row0 + ai * HALF + m * 16) * DM + col0;
#pragma unroll
                for (int bj = 0; bj < 2; ++bj)
#pragma unroll
                    for (int n = 0; n < 2; ++n) { f32x4 xv = *(const f32x4*)(rowp + bj * HALF + n * 16); xv += gv[bj][n] * acc[ai][bj][m][n]; *(f32x4*)(rowp + bj * HALF + n * 16) = xv; } }
    }
};
}

__device__ __forceinline__ void transpose_tile(const float* src, int N, int k0, int n0src, bf16_t* dst, int K, int n0dst, float* tile  ) {
    const int tid = opaque_tid();
    __syncthreads();
#pragma unroll
    for (int i = 0; i < 2; ++i) {
        const int kk = (tid >> 4) + 32 * i, c4 = (tid & 15) * 4;
        const f32x4 v = *(const f32x4*)(src + (size_t)(k0 + kk) * N + n0src + c4);
        tile[kk * 65 + c4 + 0] = v[0]; tile[kk * 65 + c4 + 1] = v[1]; tile[kk * 65 + c4 + 2] = v[2]; tile[kk * 65 + c4 + 3] = v[3];
    }
    __syncthreads();
    const int nn = tid >> 3, kg = tid & 7;
    u32x4 pk;
#pragma unroll
    for (int j = 0; j < 4; ++j) pk[j] = cvt_pk_bf16(tile[(kg * 8 + 2 * j) * 65 + nn], tile[(kg * 8 + 2 * j + 1) * 65 + nn]);
    *(u32x4*)(dst + (size_t)(n0dst + nn) * K + k0 + kg * 8) = pk;
}

__device__ __forceinline__ void phase0(const P& p, unsigned char* smem) {
    const int tid = opaque_tid(), G = gridDim.x, bid = blockIdx.x;
    float* tile = (float*)smem;
    float* sc = (float*)(smem + 32768);
    float* part = (float*)(smem + 65536);
    for (int i = tid; i < 5 * 1024; i += 512) { const int r = i >> 10, k = i & 1023; const float v = r == 0 ? p.c_ctx[k] : p.c[(r - 1) * 1024 + k]; sc[i] = siluf_(v); }
    __syncthreads();
    for (int it = bid; it < 576; it += G) {
        const int l = it / 144, jb = it % 144, col = tid & 63, kg = tid >> 6;
        const float* w = p.w_mod + (size_t)l * 1024 * NMOD + (size_t)(kg * 128) * NMOD + jb * 64 + col;
        float a0 = 0.f, a1 = 0.f, a2 = 0.f, a3 = 0.f, a4 = 0.f;
#pragma unroll 8
        for (int k = 0; k < 128; ++k) { const float wv = w[(size_t)k * NMOD]; const int kk = kg * 128 + k;
            a0 += sc[kk] * wv; a1 += sc[1024 + kk] * wv; a2 += sc[2048 + kk] * wv; a3 += sc[3072 + kk] * wv; a4 += sc[4096 + kk] * wv; }
        __syncthreads();
        part[(kg * 5 + 0) * 64 + col] = a0; part[(kg * 5 + 1) * 64 + col] = a1; part[(kg * 5 + 2) * 64 + col] = a2; part[(kg * 5 + 3) * 64 + col] = a3; part[(kg * 5 + 4) * 64 + col] = a4;
        __syncthreads();
        if (tid < 320) { const int r = tid >> 6, cc = tid & 63; float s = p.b_mod[l * NMOD + jb * 64 + cc];
#pragma unroll
            for (int q = 0; q < 8; ++q) s += part[(q * 5 + r) * 64 + cc];
            p.mod[((size_t)l * 5 + r) * NMOD + jb * 64 + cc] = s; }
    }
    for (int it = bid; it < 8 * 1408; it += G) {
        const int mi = it / 1408, r = it % 1408, tk = r / 88, tn = r % 88;
        const int n0dst = tn * 64, pn = n0dst >> 8, w = n0dst & 255, bj = w >> 7, i0 = w & 127, n0src = bj * DFF + pn * 128 + i0;
        transpose_tile(p.ffn_w_in + (size_t)mi * 1024 * 5632, 5632, tk * 64, n0src, p.wt_ffn_in + (size_t)mi * 5632 * 1024, 1024, n0dst, tile);
    }
    for (int it = bid; it < 8 * 704; it += G) {
        const int mi = it / 704, r = it % 704, tk = r / 16, tn = r % 16;
        transpose_tile(p.ffn_w_out + (size_t)mi * DFF * 1024, 1024, tk * 64, tn * 64, p.wt_ffn_out + (size_t)mi * 1024 * DFF, DFF, tn * 64, tile);
    }
    for (int it = bid; it < 4 * 704; it += G) {
        const int mi = it / 704, r = it % 704, tk = r / 44, tn = r % 44;
        transpose_tile(p.w_in + (size_t)mi * 1024 * NPROJ, NPROJ, tk * 64, tn * 64, p.wt_in + (size_t)mi * NPROJ * 1024, 1024, tn * 64, tile);
    }
    for (int it = bid; it < 4 * 256; it += G) {
        const int mi = it / 256, r = it % 256, tk = r / 16, tn = r % 16;
        transpose_tile(p.w_out + (size_t)mi * 1024 * 1024, 1024, tk * 64, tn * 64, p.wt_out + (size_t)mi * 1024 * 1024, 1024, tn * 64, tile);
    }
    const int gt = bid * 512 + tid, GT = G * 512;
    for (int i = gt; i < 32768; i += GT) { const int t = i >> 5, pp = i & 31, f = pp & 15;
        const float inv = powf(10000.f, -(float)f / 16.f); const float pos = pp < 16 ? (float)(t >> 6) : (float)(t & 63); const float ang = pos * inv;
        p.rope[i] = make_float2(cosf(ang), sinf(ang)); }
    for (int i = gt; i < 262144; i += GT) { const int c = i & 63, dout = (i >> 6) & 63, n = (i >> 12) & 3, g = (i >> 14) & 1, d = (i >> 15) & 1, l = i >> 16;
        const float* src = g ? p.lru_w_i : p.lru_w_r;
        p.lruWt[i] = f2bf(src[((((size_t)l * 2 + d) * 4 + n) * 64 + c) * 64 + dout]); }
    for (int i = gt; i < M_TOK * DM / 4; i += GT) { const f32x4 v = i < M_P * DM / 4 ? ((const f32x4*)p.x_prompt)[i] : ((const f32x4*)p.x_sample)[i - M_P * DM / 4]; ((f32x4*)p.out)[i] = v; }
}

__device__ __forceinline__ void norm_phase(const P& p, int l, int s) {
    const int tid = opaque_tid(), lane = tid & 63, w = tid >> 6;
    const float* ng = p.norm_g + ((size_t)l * 3 + s) * DM;
    for (int row = blockIdx.x * 8 + w; row < M_TOK; row += gridDim.x * 8) {
        const int midx = row < M_P ? 0 : 1 + ((row - M_P) >> 10);
        const float* md = p.mod + ((size_t)l * 5 + midx) * NMOD + (3 * s) * DM;
        const float* x = p.out + (size_t)row * DM;
        f32x4 v[4]; float ss = 0.f;
#pragma unroll
        for (int i = 0; i < 4; ++i) { v[i] = *(const f32x4*)(x + lane * 4 + 256 * i); ss += v[i][0] * v[i][0] + v[i][1] * v[i][1] + v[i][2] * v[i][2] + v[i][3] * v[i][3]; }
#pragma unroll
        for (int o = 1; o < 64; o <<= 1) ss += __shfl_xor(ss, o);
        const float rinv = rsqrtf(ss * (1.f / DM) + 1e-6f);
#pragma unroll
        for (int i = 0; i < 4; ++i) { const int c = lane * 4 + 256 * i;
            const f32x4 g = *(const f32x4*)(ng + c), sh = *(const f32x4*)(md + c), scl = *(const f32x4*)(md + DM + c);
            const f32x4 y = v[i] * rinv * g * (scl + 1.f) + sh;
            u32x2 pk; pk[0] = cvt_pk_bf16(y[0], y[1]); pk[1] = cvt_pk_bf16(y[2], y[3]);
            *(u32x2*)(p.h + (size_t)row * DM + c) = pk; }
    }
}

template <int MODE>
__device__ __forceinline__ void attn_item(const P& p, int l, unsigned char* smem, int b, int h, int qb) {
    constexpr bool SAMPLE = (MODE == 2 || MODE == 3 || MODE == 5);
    constexpr bool RET = (MODE >= 4);
    const int tid = opaque_tid(), lane = tid & 63, w = tid >> 6, lr = lane & 15, lg = lane >> 4;
    const int rowbase = SAMPLE ? M_P + b * 1024 : b * 256;
    int qcol, kcol, vcol, ycol; const float *qgn = nullptr, *kgn = nullptr;
    if (MODE == 0 || MODE == 2) { qcol = 512 + h * 64; kcol = 768 + (h >> 1) * 64; vcol = 896 + (h >> 1) * 64; ycol = 256 + h * 64; qgn = p.gqa_qn + l * 64; kgn = p.gqa_kn + l * 64; }
    else if (MODE == 1 || MODE == 3) { qcol = 1024 + h * 64; kcol = 1280 + h * 64; vcol = 1536 + h * 64; ycol = 512 + h * 64; qgn = p.nat_qn + l * 64; kgn = p.nat_kn + l * 64; }
    else { qcol = 1792 + h * 64; kcol = 2048 + h * 64; vcol = 2304 + h * 64; ycol = 768 + h * 64; }
    bf16_t* Ks = (bf16_t*)smem;
    bf16_t* Vt = (bf16_t*)(smem + 9216);
    float* btab = (float*)(smem + 9216 + 8704);
    const float LOG2E = 1.44269504f;
    __syncthreads();
    if (MODE == 3) { for (int i = tid; i < 465; i += 512) btab[i] = p.nat_bias[((size_t)l * 4 + h) * 465 + i] * LOG2E; }

    const int tq = qb * 128 + w * 16 + lr;
    bf16x8 qf[2];
    {
        const float* qrow = p.proj + (size_t)(rowbase + tq) * NPROJ + qcol + lg * 8;
        f32x4 q0 = *(const f32x4*)qrow, q1 = *(const f32x4*)(qrow + 4), q2 = *(const f32x4*)(qrow + 32), q3 = *(const f32x4*)(qrow + 36);
        if (!RET) {
            float ss = 0.f;
#pragma unroll
            for (int j = 0; j < 4; ++j) ss += q0[j] * q0[j] + q1[j] * q1[j] + q2[j] * q2[j] + q3[j] * q3[j];
            ss += __shfl_xor(ss, 16); ss += __shfl_xor(ss, 32);
            const float rinv = rsqrtf(ss * (1.f / 64.f) + 1e-6f);
            const float* gp = qgn + lg * 8;
            q0 = q0 * rinv * *(const f32x4*)gp; q1 = q1 * rinv * *(const f32x4*)(gp + 4); q2 = q2 * rinv * *(const f32x4*)(gp + 32); q3 = q3 * rinv * *(const f32x4*)(gp + 36);
        }
        if (MODE == 2) {
            const float2* rp = p.rope + tq * 32 + lg * 4;
            const float2 c0 = rp[0], c1 = rp[1], c2 = rp[2], c3 = rp[3], c4 = rp[16], c5 = rp[17], c6 = rp[18], c7 = rp[19];
            float a, bb;
            a = q0[0]; bb = q0[1]; q0[0] = a * c0.x - bb * c0.y; q0[1] = a * c0.y + bb * c0.x;
            a = q0[2]; bb = q0[3]; q0[2] = a * c1.x - bb * c1.y; q0[3] = a * c1.y + bb * c1.x;
            a = q1[0]; bb = q1[1]; q1[0] = a * c2.x - bb * c2.y; q1[1] = a * c2.y + bb * c2.x;
            a = q1[2]; bb = q1[3]; q1[2] = a * c3.x - bb * c3.y; q1[3] = a * c3.y + bb * c3.x;
            a = q2[0]; bb = q2[1]; q2[0] = a * c4.x - bb * c4.y; q2[1] = a * c4.y + bb * c4.x;
            a = q2[2]; bb = q2[3]; q2[2] = a * c5.x - bb * c5.y; q2[3] = a * c5.y + bb * c5.x;
            a = q3[0]; bb = q3[1]; q3[0] = a * c6.x - bb * c6.y; q3[1] = a * c6.y + bb * c6.x;
            a = q3[2]; bb = q3[3]; q3[2] = a * c7.x - bb * c7.y; q3[3] = a * c7.y + bb * c7.x;
        }
        u32x4 t0, t1;
        t0[0] = cvt_pk_bf16(q0[0], q0[1]); t0[1] = cvt_pk_bf16(q0[2], q0[3]); t0[2] = cvt_pk_bf16(q1[0], q1[1]); t0[3] = cvt_pk_bf16(q1[2], q1[3]);
        t1[0] = cvt_pk_bf16(q2[0], q2[1]); t1[1] = cvt_pk_bf16(q2[2], q2[3]); t1[2] = cvt_pk_bf16(q3[0], q3[1]); t1[3] = cvt_pk_bf16(q3[2], q3[3]);
        qf[0] = __builtin_bit_cast(bf16x8, t0); qf[1] = __builtin_bit_cast(bf16x8, t1);
    }

    int ntiles, krlo = 0;
    const int nr = 2 * qb + (w >> 2), ncq = (w & 3) * 16 + lr;
    if (MODE == 0 || MODE == 1 || MODE == 4) ntiles = 4;
    else if (MODE == 2) ntiles = 20;
    else if (MODE == 5) ntiles = 18;
    else { const int r0 = 2 * qb; krlo = min(max(r0 - 4, 0), 8); const int krhi = min(max(r0 + 1 - 4, 0), 8) + 7; ntiles = 4 + (krhi - krlo + 1); }
    float lgf = 0.f, lgb = 0.f;
    if (RET) { const float xf = p.ret_decay[(l * 2 + 0) * 4 + h], xb = p.ret_decay[(l * 2 + 1) * 4 + h];
        lgf = -log1pf(expf(-xf)) * LOG2E; lgb = -log1pf(expf(-xb)) * LOG2E; }

    f32x4 o[4];
#pragma unroll
    for (int i = 0; i < 4; ++i) o[i] = (f32x4){0.f, 0.f, 0.f, 0.f};
    float m_run = -1e30f, l_run = 0.f;
    const int skey = tid >> 3, sdg = tid & 7;

    for (int kt = 0; kt < ntiles; ++kt) {
        __syncthreads();
        {
            const float *ksrc, *vsrc; bool donorm = !RET, dorope = false, ident = false; int tk = kt * 64 + skey;
            if (MODE == 0 || MODE == 1 || MODE == 4) { ksrc = p.proj + (size_t)(rowbase + tk) * NPROJ; vsrc = ksrc + vcol + sdg * 8; ksrc += kcol + sdg * 8; }
            else if (MODE == 2) {
                if (kt < 16) { ksrc = p.proj + (size_t)(rowbase + tk) * NPROJ; vsrc = ksrc + vcol + sdg * 8; ksrc += kcol + sdg * 8; dorope = true; }
                else { const size_t off = ((((size_t)b * 4 + l) * 256 + (tk - 1024)) * 2 + (h >> 1)) * 64 + sdg * 8; ksrc = p.cbk + off; vsrc = p.cbv + off; donorm = false; }
            } else if (MODE == 3) {
                if (kt < 4) { const size_t off = ((((size_t)b * 4 + l) * 256 + tk) * 4 + h) * 64 + sdg * 8; ksrc = p.cck + off; vsrc = p.ccv + off; donorm = false; }
                else { tk = (krlo + kt - 4) * 64 + skey; ksrc = p.proj + (size_t)(rowbase + tk) * NPROJ; vsrc = ksrc + vcol + sdg * 8; ksrc += kcol + sdg * 8; }
            } else {
                if (kt < 16) { ksrc = p.proj + (size_t)(rowbase + tk) * NPROJ; vsrc = ksrc + vcol + sdg * 8; ksrc += kcol + sdg * 8; }
                else { ident = true; vsrc = p.st_ret + ((((((size_t)b * 4 + l) * 2 + (kt - 16)) * 4 + h) * 64 + skey) * 64) + sdg * 8; ksrc = vsrc; }
            }
            f32x4 k0, k1;
            const f32x4 v0 = *(const f32x4*)vsrc, v1 = *(const f32x4*)(vsrc + 4);
            if (ident) {
#pragma unroll
                for (int j = 0; j < 4; ++j) { k0[j] = (sdg * 8 + j == skey) ? 1.f : 0.f; k1[j] = (sdg * 8 + 4 + j == skey) ? 1.f : 0.f; }
            } else { k0 = *(const f32x4*)ksrc; k1 = *(const f32x4*)(ksrc + 4); }
            if (donorm) {
                float ss = 0.f;
#pragma unroll
                for (int j = 0; j < 4; ++j) ss += k0[j] * k0[j] + k1[j] * k1[j];
                ss += __shfl_xor(ss, 1); ss += __shfl_xor(ss, 2); ss += __shfl_xor(ss, 4);
                const float rinv = rsqrtf(ss * (1.f / 64.f) + 1e-6f);
                k0 = k0 * rinv * *(const f32x4*)(kgn + sdg * 8); k1 = k1 * rinv * *(const f32x4*)(kgn + sdg * 8 + 4);
            }
            if (MODE == 2 && dorope) {
                const float2* rp = p.rope + tk * 32 + sdg * 4;
                const float2 c0 = rp[0], c1 = rp[1], c2 = rp[2], c3 = rp[3];
                float a, bb;
                a = k0[0]; bb = k0[1]; k0[0] = a * c0.x - bb * c0.y; k0[1] = a * c0.y + bb * c0.x;
                a = k0[2]; bb = k0[3]; k0[2] = a * c1.x - bb * c1.y; k0[3] = a * c1.y + bb * c1.x;
                a = k1[0]; bb = k1[1]; k1[0] = a * c2.x - bb * c2.y; k1[1] = a * c2.y + bb * c2.x;
                a = k1[2]; bb = k1[3]; k1[2] = a * c3.x - bb * c3.y; k1[3] = a * c3.y + bb * c3.x;
            }
            if (MODE == 0) { if (qb == 0 && (h & 1) == 0) { const size_t off = ((((size_t)b * 4 + l) * 256 + tk) * 2 + (h >> 1)) * 64 + sdg * 8;
                *(f32x4*)(p.out + OFF_BK + off) = k0; *(f32x4*)(p.out + OFF_BK + off + 4) = k1; *(f32x4*)(p.out + OFF_BV + off) = v0; *(f32x4*)(p.out + OFF_BV + off + 4) = v1; } }
            if (MODE == 1) { if (qb == 0) { const size_t off = ((((size_t)b * 4 + l) * 256 + tk) * 4 + h) * 64 + sdg * 8;
                *(f32x4*)(p.out + OFF_CK + off) = k0; *(f32x4*)(p.out + OFF_CK + off + 4) = k1; *(f32x4*)(p.out + OFF_CV + off) = v0; *(f32x4*)(p.out + OFF_CV + off + 4) = v1; } }
            u32x4 pk; pk[0] = cvt_pk_bf16(k0[0], k0[1]); pk[1] = cvt_pk_bf16(k0[2], k0[3]); pk[2] = cvt_pk_bf16(k1[0], k1[1]); pk[3] = cvt_pk_bf16(k1[2], k1[3]);
            *(u32x4*)(Ks + skey * 72 + sdg * 8) = pk;
#pragma unroll
            for (int j = 0; j < 4; ++j) { Vt[(sdg * 8 + j) * 68 + skey] = f2bf(v0[j]); Vt[(sdg * 8 + 4 + j) * 68 + skey] = f2bf(v1[j]); }
        }
        __syncthreads();
        f32x4 s[4];
#pragma unroll
        for (int ks = 0; ks < 4; ++ks) {
            s[ks] = (f32x4){0.f, 0.f, 0.f, 0.f};
#pragma unroll
            for (int st = 0; st < 2; ++st) { const bf16x8 kf = *(const bf16x8*)(Ks + (16 * ks + lr) * 72 + lg * 8 + 32 * st); s[ks] = MFMA16(kf, qf[st], s[ks]); }
        }
        if (!RET) {
            const float SC = 0.125f * LOG2E;
            float mx = -1e30f;
#pragma unroll
            for (int ks = 0; ks < 4; ++ks)
#pragma unroll
                for (int i = 0; i < 4; ++i) {
                    float v = s[ks][i] * SC;
                    if (MODE == 3) { if (kt >= 4) {
                        const int kr = krlo + kt - 4, kc = 16 * ks + lg * 4 + i;
                        const int rs = min(max(nr - 4, 0), 8), cs = min(max(ncq - 8, 0), 48);
                        const bool valid = (kr >= rs) && (kr < rs + 8) && (kc >= cs) && (kc < cs + 16);
                        const int bi = valid ? (kr - nr + 7) * 31 + (kc - ncq + 15) : 0;
                        v = valid ? v + btab[bi] : -1e30f; } }
                    s[ks][i] = v; mx = fmaxf(mx, v);
                }
            mx = fmaxf(mx, __shfl_xor(mx, 16)); mx = fmaxf(mx, __shfl_xor(mx, 32));
            const float mnew = fmaxf(m_run, mx), alpha = fexp2(m_run - mnew);
            m_run = mnew; l_run *= alpha;
#pragma unroll
            for (int dt = 0; dt < 4; ++dt) o[dt] *= alpha;
#pragma unroll
            for (int ks = 0; ks < 4; ++ks)
#pragma unroll
                for (int i = 0; i < 4; ++i) { const float pv = fexp2(s[ks][i] - mnew); l_run += pv; s[ks][i] = pv; }
        } else {
            if (MODE == 5 && kt >= 16) {
                const float scl = kt == 16 ? fexp2((float)(tq + 1) * lgf) : fexp2((float)(1024 - tq) * lgb);
#pragma unroll
                for (int ks = 0; ks < 4; ++ks) s[ks] *= scl;
            } else {
#pragma unroll
                for (int ks = 0; ks < 4; ++ks)
#pragma unroll
                    for (int i = 0; i < 4; ++i) { const int ts = kt * 64 + 16 * ks + lg * 4 + i; const int df = tq - ts;
                        const float dec = df > 0 ? fexp2((float)df * lgf) : (df < 0 ? fexp2((float)(-df) * lgb) : 2.f);
                        s[ks][i] *= 0.125f * dec; }
            }
        }
#pragma unroll
        for (int kp = 0; kp < 2; ++kp) {
            u32x4 pk; pk[0] = cvt_pk_bf16(s[2 * kp][0], s[2 * kp][1]); pk[1] = cvt_pk_bf16(s[2 * kp][2], s[2 * kp][3]);
            pk[2] = cvt_pk_bf16(s[2 * kp + 1][0], s[2 * kp + 1][1]); pk[3] = cvt_pk_bf16(s[2 * kp + 1][2], s[2 * kp + 1][3]);
            const bf16x8 pf = __builtin_bit_cast(bf16x8, pk);
#pragma unroll
            for (int dt = 0; dt < 4; ++dt) {
                const bf16_t* vp = Vt + (16 * dt + lr) * 68 + 32 * kp + lg * 4;
                const u32x2 lo = *(const u32x2*)vp, hi = *(const u32x2*)(vp + 16);
                u32x4 vv; vv[0] = lo[0]; vv[1] = lo[1]; vv[2] = hi[0]; vv[3] = hi[1];
                o[dt] = MFMA16(__builtin_bit_cast(bf16x8, vv), pf, o[dt]);
            }
        }
    }
    bf16_t* yrow = p.ycat + (size_t)(rowbase + tq) * DM + ycol + lg * 4;
    if (!RET) {
        l_run += __shfl_xor(l_run, 16); l_run += __shfl_xor(l_run, 32);
        const float inv = 1.f / l_run;
#pragma unroll
        for (int dt = 0; dt < 4; ++dt) { u32x2 pk; pk[0] = cvt_pk_bf16(o[dt][0] * inv, o[dt][1] * inv); pk[1] = cvt_pk_bf16(o[dt][2] * inv, o[dt][3] * inv); *(u32x2*)(yrow + 16 * dt) = pk; }
    } else {
        float sm = 0.f;
#pragma unroll
        for (int dt = 0; dt < 4; ++dt) sm += o[dt][0] + o[dt][1] + o[dt][2] + o[dt][3];
        sm += __shfl_xor(sm, 16); sm += __shfl_xor(sm, 32);
        const float mu = sm * (1.f / 64.f);
        float vs = 0.f;
#pragma unroll
        for (int dt = 0; dt < 4; ++dt)
#pragma unroll
            for (int i = 0; i < 4; ++i) { const float dlt = o[dt][i] - mu; vs += dlt * dlt; }
        vs += __shfl_xor(vs, 16); vs += __shfl_xor(vs, 32);
        const float rstd = rsqrtf(vs * (1.f / 64.f) + 1e-6f);
        const float* gdp = p.proj + (size_t)(rowbase + tq) * NPROJ + 2560 + h * 64 + lg * 4;
        const float* gnp = p.ret_gn + l * 256 + h * 64 + lg * 4;
#pragma unroll
        for (int dt = 0; dt < 4; ++dt) {
            const f32x4 gd = *(const f32x4*)(gdp + 16 * dt), gn = *(const f32x4*)(gnp + 16 * dt);
            float y[4];
#pragma unroll
            for (int i = 0; i < 4; ++i) y[i] = (o[dt][i] - mu) * rstd * gn[i] * siluf_(gd[i]);
            u32x2 pk; pk[0] = cvt_pk_bf16(y[0], y[1]); pk[1] = cvt_pk_bf16(y[2], y[3]); *(u32x2*)(yrow + 16 * dt) = pk;
        }
    }
}

__device__ __forceinline__ void ret_state_item(const P& p, int l, unsigned char* smem, int b, int h) {
    const int tid = opaque_tid();
    float* Kl = (float*)smem; float* Vl = Kl + 16384; float* wf = Vl + 16384; float* wb = wf + 256;
    __syncthreads();
    const float LOG2E = 1.44269504f;
    const float lgf = -log1pf(expf(-p.ret_decay[(l * 2 + 0) * 4 + h])) * LOG2E, lgb = -log1pf(expf(-p.ret_decay[(l * 2 + 1) * 4 + h])) * LOG2E;
    if (tid < 256) { wf[tid] = 0.125f * fexp2((float)(255 - tid) * lgf); wb[tid] = 0.125f * fexp2((float)tid * lgb); }
#pragma unroll
    for (int i = 0; i < 8; ++i) { const int e = tid + 512 * i, s = e >> 4, c4 = (e & 15) * 4;
        const float* row = p.proj + (size_t)(b * 256 + s) * NPROJ + h * 64 + c4;
        *(f32x4*)(Kl + s * 64 + c4) = *(const f32x4*)(row + 2048); *(f32x4*)(Vl + s * 64 + c4) = *(const f32x4*)(row + 2304); }
    __syncthreads();
    const int e = tid & 63, dg = tid >> 6;
    f32x4 af0 = {0.f, 0.f, 0.f, 0.f}, af1 = af0, ab0 = af0, ab1 = af0;
    for (int s = 0; s < 256; ++s) {
        const float v = Vl[s * 64 + e], vf = v * wf[s], vb = v * wb[s];
        const f32x4 k0 = *(const f32x4*)(Kl + s * 64 + dg * 8), k1 = *(const f32x4*)(Kl + s * 64 + dg * 8 + 4);
        af0 += k0 * vf; af1 += k1 * vf; ab0 += k0 * vb; ab1 += k1 * vb;
    }
    float* of = p.out + OFF_RET + ((((size_t)b * 4 + l) * 2 + 0) * 4 + h) * 4096 + (dg * 8) * 64 + e;
    float* ob = p.out + OFF_RET + ((((size_t)b * 4 + l) * 2 + 1) * 4 + h) * 4096 + (dg * 8) * 64 + e;
#pragma unroll
    for (int j = 0; j < 4; ++j) { of[j * 64] = af0[j]; of[(4 + j) * 64] = af1[j]; ob[j * 64] = ab0[j]; ob[(4 + j) * 64] = ab1[j]; }
}

__device__ __forceinline__ void lru_item(const P& p, int l, unsigned char* smem, int bg, int n) {
    const int tid = opaque_tid(), lane = tid & 63, w = tid >> 6, lr = lane & 15, lg = lane >> 4;
    const bool sample = bg >= 32;
    const int T = sample ? 1024 : 256, rowbase = sample ? M_P + (bg - 32) * 1024 : bg * 256, nch = T >> 7;
    bf16_t* Wt = (bf16_t*)smem;
    bf16_t* xcb = (bf16_t*)(smem + 18432);
    float* uL = (float*)(smem + 36864);
    float* aL = (float*)(smem + 71680);
    float* segA = (float*)(smem + 106496);
    float* segB = segA + 512;
    const int ch = lane;
    const int c4 = (tid & 15) * 4;
    f32x4 cw0 = *(const f32x4*)(p.conv_w + ((size_t)l * 4 + 0) * 256 + n * 64 + c4), cw1 = *(const f32x4*)(p.conv_w + ((size_t)l * 4 + 1) * 256 + n * 64 + c4),
          cw2 = *(const f32x4*)(p.conv_w + ((size_t)l * 4 + 2) * 256 + n * 64 + c4), cw3 = *(const f32x4*)(p.conv_w + ((size_t)l * 4 + 3) * 256 + n * 64 + c4),
          cbv = *(const f32x4*)(p.conv_b + (size_t)l * 256 + n * 64 + c4);
    for (int d = 0; d < 2; ++d) {
        __syncthreads();
#pragma unroll
        for (int i = 0; i < 2; ++i) { const u32x4 v = *(const u32x4*)(p.lruWt + ((((size_t)l * 2 + d) * 2 + i) * 4 + n) * 4096 + tid * 8);
            *(u32x4*)(Wt + (i * 64 + (tid >> 3)) * 72 + (tid & 7) * 8) = v; }
        float sp[4], br[4], bi[4];
#pragma unroll
        for (int ct = 0; ct < 4; ++ct) { const int cidx = (l * 2 + d) * 256 + n * 64 + 16 * ct + lr;
            sp[ct] = log1pf(expf(-p.lru_lambda[cidx])); br[ct] = p.lru_b_r[cidx]; bi[ct] = p.lru_b_i[cidx]; }
        float carry = sample ? p.st_lru[(((size_t)(bg - 32) * 4 + l) * 2 + d) * 256 + n * 64 + ch] : 0.f;
        for (int cc = 0; cc < nch; ++cc) {
            const int ci = d == 0 ? cc : nch - 1 - cc, t0 = ci * 128;
            __syncthreads();
#pragma unroll
            for (int k = 0; k < 4; ++k) {
                const int tt = (tid >> 4) + 32 * k, t = t0 + tt;
                const float* base = p.proj + (size_t)(rowbase + t) * NPROJ + n * 64 + c4;
                f32x4 acc = cbv;
                if (t - 2 >= 0) acc += cw0 * *(const f32x4*)(base - 2 * NPROJ);
                if (t - 1 >= 0) acc += cw1 * *(const f32x4*)(base - NPROJ);
                acc += cw2 * *(const f32x4*)base;
                if (t + 1 < T) acc += cw3 * *(const f32x4*)(base + NPROJ);
                *(f32x4*)(uL + tt * 68 + c4) = acc;
                u32x2 pk; pk[0] = cvt_pk_bf16(acc[0], acc[1]); pk[1] = cvt_pk_bf16(acc[2], acc[3]);
                *(u32x2*)(xcb + tt * 72 + c4) = pk;
            }
            __syncthreads();
            f32x4 acc[2][4];
#pragma unroll
            for (int g = 0; g < 2; ++g)
#pragma unroll
                for (int ct = 0; ct < 4; ++ct) acc[g][ct] = (f32x4){0.f, 0.f, 0.f, 0.f};
#pragma unroll
            for (int st = 0; st < 2; ++st) {
                const bf16x8 af = *(const bf16x8*)(xcb + (16 * w + lr) * 72 + lg * 8 + 32 * st);
#pragma unroll
                for (int g = 0; g < 2; ++g)
#pragma unroll
                    for (int ct = 0; ct < 4; ++ct) { const bf16x8 bf = *(const bf16x8*)(Wt + (g * 64 + 16 * ct + lr) * 72 + lg * 8 + 32 * st); acc[g][ct] = MFMA16(af, bf, acc[g][ct]); }
            }
#pragma unroll
            for (int ct = 0; ct < 4; ++ct)
#pragma unroll
                for (int i = 0; i < 4; ++i) {
                    const int tok = 16 * w + lg * 4 + i, dout = 16 * ct + lr;
                    const float r = sigmoidf_(acc[0][ct][i] + br[ct]), ig = sigmoidf_(acc[1][ct][i] + bi[ct]);
                    const float la = -8.f * r * sp[ct], a = expf(la), xc = uL[tok * 68 + dout];
                    const float u = sqrtf(-expm1f(2.f * la)) * ig * xc;
                    aL[tok * 68 + dout] = a; uL[tok * 68 + dout] = u;
                }
            __syncthreads();
            const int seg = d == 0 ? w : 7 - w;
            { float A = 1.f, Bv = 0.f;
#pragma unroll
              for (int k = 0; k < 16; ++k) { const int tok = 16 * w + (d == 0 ? k : 15 - k); const float a = aL[tok * 68 + ch], u = uL[tok * 68 + ch]; Bv = a * Bv + u; A *= a; }
              segA[seg * 64 + ch] = A; segB[seg * 64 + ch] = Bv; }
            __syncthreads();
            float hin = carry, hall = carry;
#pragma unroll
            for (int sgi = 0; sgi < 8; ++sgi) { if (sgi == seg) hin = hall; hall = segA[sgi * 64 + ch] * hall + segB[sgi * 64 + ch]; }
            carry = hall;
            float hh = hin;
#pragma unroll
            for (int k = 0; k < 16; ++k) {
                const int tok = 16 * w + (d == 0 ? k : 15 - k); const float a = aL[tok * 68 + ch], u = uL[tok * 68 + ch]; hh = a * hh + u;
                const size_t row = (size_t)(rowbase + t0 + tok);
                if (d == 0) p.hf[row * 256 + n * 64 + ch] = hh;
                else { const float hfv = p.hf[row * 256 + n * 64 + ch], ga = p.proj[row * NPROJ + 256 + n * 64 + ch];
                    const float gl = 0.5f * ga * (1.f + tanhf(0.7978845608f * (ga + 0.044715f * ga * ga * ga)));
                    p.ycat[row * DM + n * 64 + ch] = f2bf((hfv + hh) * gl); }
            }
        }
        if (!sample && w == 0) p.out[OFF_LRU + (((size_t)bg * 4 + l) * 2 + d) * 256 + n * 64 + ch] = carry;
    }
}

__device__ __forceinline__ void mixer_phase(const P& p, int l, unsigned char* smem) {
    for (int it = blockIdx.x; it < 1424; it += gridDim.x) {
        if (it < 16) lru_item(p, l, smem, 32 + (it >> 2), it & 3);
        else if (it < 144) { const int i = it - 16; attn_item<2>(p, l, smem, i >> 5, (i >> 3) & 3, i & 7); }
        else if (it < 272) { const int i = it - 144; attn_item<5>(p, l, smem, i >> 5, (i >> 3) & 3, i & 7); }
        else if (it < 400) { const int i = it - 272; attn_item<3>(p, l, smem, i >> 5, (i >> 3) & 3, i & 7); }
        else if (it < 528) { const int i = it - 400; lru_item(p, l, smem, i >> 2, i & 3); }
        else if (it < 784) { const int i = it - 528; attn_item<0>(p, l, smem, i >> 3, (i >> 1) & 3, i & 1); }
        else if (it < 1040) { const int i = it - 784; attn_item<1>(p, l, smem, i >> 3, (i >> 1) & 3, i & 1); }
        else if (it < 1296) { const int i = it - 1040; attn_item<4>(p, l, smem, i >> 3, (i >> 1) & 3, i & 1); }
        else { const int i = it - 1296; ret_state_item(p, l, smem, i >> 2, i & 3); }
    }
}

__global__ void __launch_bounds__(512, 2) mega(P p) {
    extern __shared__ __attribute__((aligned(16))) unsigned char smem[];
    cg::grid_group grid = cg::this_grid();
    LAS unsigned char* lds = (LAS unsigned char*)smem;
    volatile LAS unsigned* xbw = (volatile LAS unsigned*)(lds + (LDS_BYTES - 16));
    if (threadIdx.x == 0) { xbw[0] = 0u; xbw[1] = 0u; }
    __syncthreads();
    const XcdBarrier xb = xcd_barrier_post(p.bar, xbw);
    phase0(p, smem);
    grid.sync();
#define GSYNC() xcd_barrier(xb)
    pg8::StaticOrder S;
    for (int l = 0; l < 4; ++l) {
        for (int s = 0; s < 3; ++s) {
            norm_phase(p, l, s);
            GSYNC();
            pg8::Gemm g2; float coef;
            if (s != 1) {
                const int sl = s >> 1;
                pg8::Gemm g{p.h, p.wt_ffn_in + ((size_t)l * 2 + sl) * 5632 * 1024, M_TOK, 5632, 1024};
                S.init(M_TOK, 5632, gridDim.x, blockIdx.x);
                pg8::gemm_phase(lds, g, S, pg8::EpiSwiGLU{p.act});
                GSYNC();
                g2 = pg8::Gemm{p.act, p.wt_ffn_out + ((size_t)l * 2 + sl) * 1024 * DFF, M_TOK, 1024, DFF}; coef = 0.5f;
            } else {
                pg8::Gemm g{p.h, p.wt_in + (size_t)l * NPROJ * 1024, M_TOK, NPROJ, 1024};
                S.init(M_TOK, NPROJ, gridDim.x, blockIdx.x);
                pg8::gemm_phase(lds, g, S, pg8::EpiF32{p.proj, NPROJ});
                GSYNC();
                mixer_phase(p, l, smem);
                GSYNC();
                g2 = pg8::Gemm{p.ycat, p.wt_out + (size_t)l * 1024 * 1024, M_TOK, 1024, 1024}; coef = 1.0f;
            }
            S.init(M_TOK, 1024, gridDim.x, blockIdx.x);
            pg8::gemm_phase(lds, g2, S, pg8::EpiResid{p.out, p.mod + (size_t)l * 5 * NMOD + (3 * s + 2) * DM, coef});
            GSYNC();
        }
    }
}

extern "C" void kernel_launch(void* const* d_in, const int* in_sizes, int n_in, void* d_out, int out_size, void* d_ws, size_t ws_size, hipStream_t stream) {
    static int grid_blocks = 0;
    if (!grid_blocks) {
        (void)hipFuncSetAttribute((const void*)mega, hipFuncAttributeMaxDynamicSharedMemorySize, LDS_BYTES);
        int dev = 0, cus = 0, per_cu = 0;
        (void)hipGetDevice(&dev);
        (void)hipDeviceGetAttribute(&cus, hipDeviceAttributeMultiprocessorCount, dev);
        (void)hipOccupancyMaxActiveBlocksPerMultiprocessor(&per_cu, mega, 512, LDS_BYTES);
        if (per_cu > 1) per_cu = 1;
        grid_blocks = cus * per_cu;
        if (grid_blocks <= 0) grid_blocks = 256;
    }
    P p{};
    const float** pf = (const float**)&p;
    for (int i = 0; i < 31; ++i) pf[i] = (const float*)d_in[i];
    p.out = (float*)d_out;
    char* ws = (char*)d_ws; size_t off = 0;
    auto carve = [&](size_t bytes) { char* r = ws + off; off += (bytes + 255) & ~(size_t)255; return r; };
    p.wt_ffn_in = (bf16_t*)carve((size_t)8 * 5632 * 1024 * 2);
    p.wt_ffn_out = (bf16_t*)carve((size_t)8 * 1024 * DFF * 2);
    p.wt_in = (bf16_t*)carve((size_t)4 * NPROJ * 1024 * 2);
    p.wt_out = (bf16_t*)carve((size_t)4 * 1024 * 1024 * 2);
    p.lruWt = (bf16_t*)carve((size_t)262144 * 2);
    p.mod = (float*)carve((size_t)4 * 5 * NMOD * 4);
    p.rope = (float2*)carve((size_t)32768 * 8);
    p.h = (bf16_t*)carve((size_t)M_TOK * DM * 2);
    p.act = (bf16_t*)carve((size_t)M_TOK * DFF * 2);
    p.ycat = (bf16_t*)carve((size_t)M_TOK * DM * 2);
    p.proj = (float*)carve((size_t)M_TOK * NPROJ * 4);
    p.hf = (float*)carve((size_t)M_TOK * 256 * 4);
    p.bar = (unsigned*)carve((size_t)XCD_BAR_WORDS * 4);
    (void)hipMemsetAsync(p.bar, 0, (size_t)XCD_BAR_WORDS * 4, stream);
    void* args[] = {&p};
    hipError_t e = hipLaunchCooperativeKernel((void*)mega, dim3(grid_blocks), dim3(512), args, LDS_BYTES, stream);
    if (e != hipSuccess) fprintf(stderr, "cooperative launch failed: %s (grid %d)\n", hipGetErrorString(e), grid_blocks);
}
```

```cpp
#include <hip/hip_runtime.h>
#include <hip/hip_cooperative_groups.h>
#include <cstdio>
namespace cg = cooperative_groups;

#define LAS __attribute__((address_space(3)))
typedef unsigned short bf16_t;
typedef short bf16x8 __attribute__((ext_vector_type(8)));
typedef short bf16x4 __attribute__((ext_vector_type(4)));
typedef float f32x4 __attribute__((ext_vector_type(4)));
typedef unsigned u32x4 __attribute__((ext_vector_type(4)));
typedef unsigned u32x2 __attribute__((ext_vector_type(2)));

constexpr int M_TOK = 12288, M_P = 8192, DM = 1024, DFF = 2816, NPROJ = 2816, NMOD = 9216;
constexpr int LDS_BYTES = 139264;
constexpr size_t OFF_Y = 0, OFF_BK = 12582912, OFF_BV = OFF_BK + 4194304, OFF_CK = OFF_BV + 4194304, OFF_CV = OFF_CK + 8388608,
                 OFF_LRU = OFF_CV + 8388608, OFF_RET = OFF_LRU + 65536;

struct P {
    const float *x_prompt, *x_sample, *cbk, *cbv, *cck, *ccv, *st_lru, *st_ret, *c, *c_ctx, *w_mod, *b_mod, *norm_g, *ffn_w_in, *ffn_w_out,
        *w_in, *w_out, *conv_w, *conv_b, *lru_w_r, *lru_b_r, *lru_w_i, *lru_b_i, *lru_lambda, *gqa_qn, *gqa_kn, *nat_qn, *nat_kn, *nat_bias,
        *ret_decay, *ret_gn;
    float* out;
    bf16_t *wt_ffn_in, *wt_ffn_out, *wt_in, *wt_out, *lruWt;
    float* mod; float2* rope;
    bf16_t *h, *act, *ycat; float *proj, *hf;
    unsigned* bar;
};

__device__ __forceinline__ unsigned cvt_pk_bf16(float lo, float hi) { unsigned r; asm volatile("v_cvt_pk_bf16_f32 %0, %1, %2" : "=v"(r) : "v"(lo), "v"(hi)); return r; }
__device__ __forceinline__ bf16_t f2bf(float f) { return (bf16_t)(cvt_pk_bf16(f, 0.f) & 0xffffu); }
__device__ __forceinline__ float fexp2(float x) { return __builtin_amdgcn_exp2f(x); }
__device__ __forceinline__ float sigmoidf_(float x) { return 1.f / (1.f + __expf(-x)); }
__device__ __forceinline__ float siluf_(float x) { return x / (1.f + __expf(-x)); }
__device__ __forceinline__ int opaque_tid() { int t = threadIdx.x; asm volatile("" : "+v"(t)); return t; }
#define MFMA16(a, b, c) __builtin_amdgcn_mfma_f32_16x16x32_bf16((a), (b), (c), 0, 0, 0)


#define XB_TMO      128
#define XB_XCNT(j)  (256  + 64 * (j))
#define XB_XSUB(j)  (1280 + 64 * (j))
#define XB_XGEN(j)  (2304 + 64 * (j))
#define XB_TOP      3328
#define XB_TOPGEN   3392
#define XCD_BAR_WORDS 3456
#define XB_SPIN_CAP (1u << 18)
__device__ __forceinline__ unsigned xb_ld(unsigned* p)              { return __hip_atomic_load(p, __ATOMIC_RELAXED, __HIP_MEMORY_SCOPE_AGENT); }
__device__ __forceinline__ unsigned xb_add(unsigned* p, unsigned v) { return __hip_atomic_fetch_add(p, v, __ATOMIC_RELAXED, __HIP_MEMORY_SCOPE_AGENT); }
__device__ __forceinline__ unsigned xb_xcc_id() { return (unsigned)__builtin_amdgcn_s_getreg((3 << 11) | 20) & 0xFu; }
#define XB_SPIN(cond, bar) do { unsigned _sp = 0; while (cond) { __builtin_amdgcn_s_sleep(1); \
    if ((++_sp & 255u) == 0u) { if (xb_ld(&(bar)[XB_TMO])) break; if (_sp > XB_SPIN_CAP) { atomicAdd(&(bar)[XB_TMO], 1u); break; } } } } while (0)
struct XcdBarrier { unsigned* bar; unsigned x; volatile LAS unsigned* st; };
__device__ __forceinline__ XcdBarrier xcd_barrier_post(unsigned* bar, volatile LAS unsigned* st) {
    XcdBarrier b; b.bar = bar; b.x = xb_xcc_id(); b.st = st;
    if (threadIdx.x == 0) (void)xb_add(&bar[XB_XCNT(b.x)], 1u);
    return b;
}
__device__ __forceinline__ void xcd_barrier_complete(unsigned* bar, unsigned x, unsigned& nloc, unsigned& nx) {
    const unsigned G = gridDim.x * gridDim.y * gridDim.z;
    unsigned sum, cnt, mine, sp = 0u;
    for (;;) {
        sum = 0u; cnt = 0u; mine = 0u;
#pragma unroll
        for (unsigned j = 0; j < 16; ++j) { const unsigned c = xb_ld(&bar[XB_XCNT(j)]); sum += c; cnt += (c > 0u) ? 1u : 0u; mine = (j == x) ? c : mine; }
        if (sum == G) break;
        __builtin_amdgcn_s_sleep(1);
        if ((++sp & 255u) == 0u) { if (xb_ld(&bar[XB_TMO])) break; if (sp > XB_SPIN_CAP) { atomicAdd(&bar[XB_TMO], 1u); break; } }
    }
    nloc = mine > 0u ? mine : 1u; nx = cnt > 0u ? cnt : 1u;
}
__device__ __forceinline__ void xcd_barrier(const XcdBarrier& b) {
    asm volatile("s_waitcnt vmcnt(0)" ::: "memory");
    __syncthreads();
    if (threadIdx.x == 0) {
        unsigned* bar = b.bar;
        __builtin_amdgcn_s_waitcnt(0);
        unsigned nloc = b.st[0], nx = b.st[1];
        if (nloc == 0u) { xcd_barrier_complete(bar, b.x, nloc, nx); b.st[0] = nloc; b.st[1] = nx; }
        const unsigned old = xb_add(&bar[XB_XSUB(b.x)], 1u);
        const unsigned gen = old / nloc;
        if (old + 1u == (gen + 1u) * nloc) {
            __builtin_amdgcn_fence(__ATOMIC_RELEASE, "agent");
            asm volatile("s_waitcnt vmcnt(0)" ::: "memory");
            const unsigned og = xb_add(&bar[XB_TOP], 1u);
            const unsigned tg = og / nx;
            if (og + 1u == (tg + 1u) * nx) xb_add(&bar[XB_TOPGEN], 1u);
            else XB_SPIN(xb_ld(&bar[XB_TOPGEN]) == tg, bar);
            __builtin_amdgcn_fence(__ATOMIC_ACQUIRE, "agent");
            xb_add(&bar[XB_XGEN(b.x)], 1u);
            asm volatile("s_waitcnt vmcnt(0)" ::: "memory");
        } else {
            XB_SPIN(xb_ld(&bar[XB_XGEN(b.x)]) == gen, bar);
            __builtin_amdgcn_fence(__ATOMIC_ACQUIRE, "agent");
            asm volatile("s_waitcnt vmcnt(0)" ::: "memory");
        }
    }
    __syncthreads();
}

namespace pg8 {
constexpr int BM = 256, BK = 64, HALF = 128, HTB = HALF * BK * 2, STAGE_BYTES = 8 * HTB, NXCD = 8, WGM = 8;
__device__ __forceinline__ int lds_byte(int r, int c) { const int st = (r >> 4) * 2 + (c >> 5), rr = r & 15, cc = c & 31, ob = rr * 64 + cc * 2; return st * 1024 + (ob ^ (((ob >> 9) & 1) << 5)); }
__device__ __forceinline__ void stage_rc(int b, int& R, int& C) { const int st = b / 1024, sb = b % 1024, swz = sb ^ (((sb >> 9) & 1) << 5); R = (st >> 1) * 16 + swz / 64; C = (st & 1) * 32 + (swz % 64) / 2; }
__device__ __forceinline__ int perm32(int rho) { const int n = rho >> 4, i = rho & 15; return 8 * (i >> 2) + 4 * n + (i & 3); }
struct Unit { int pm, pn; };
struct Gemm { const bf16_t* A; const bf16_t* Bt; int M, N, K; };
struct StaticOrder {
    int nM, nN, nwg, G, c;
    __device__ void init(int M, int N, int G_, int c_) { nM = M / BM; nN = N / BM; nwg = nM * nN; G = G_; c = c_; }
    __device__ bool next(int i, Unit& u) const {
        const long L = (long)i * G + c; if (L >= nwg) return false;
        int wgid = (int)L; { const int q = nwg / NXCD, r = nwg % NXCD, xcd = wgid % NXCD, off = wgid / NXCD; wgid = (xcd < r ? xcd * (q + 1) : r * (q + 1) + (xcd - r) * q) + off; }
        const int nig = WGM * nN, gid = wgid / nig, fm = gid * WGM, gsz = (nM - fm) < WGM ? (nM - fm) : WGM;
        u.pm = fm + ((wgid % nig) % gsz); u.pn = (wgid % nig) / gsz; return true;
    }
};

template <class Epi, class Sched>
__device__ __forceinline__ void gemm_phase(LAS unsigned char* lds, const Gemm g, const Sched& S, const Epi& E) {
    const int tid = opaque_tid(), wid = __builtin_amdgcn_readfirstlane(tid >> 6), lane = tid & 63, wr = wid >> 2, wc = wid & 3, fr = lane & 15, fq = lane >> 4;
    const int K = g.K, nt = K / BK;
    unsigned voffA[2], voffB[2];
#pragma unroll
    for (int i = 0; i < 2; ++i) { int R, C; stage_rc(tid * 16 + i * 8192, R, C); const int Rb = Epi::PERM ? ((R & ~31) + perm32(R & 31)) : R;
        voffA[i] = (unsigned)(R * K + C) * 2u; voffB[i] = (unsigned)(Rb * K + C) * 2u; }
    const size_t kstep = (size_t)(BK * 2);
    const size_t hstep = (size_t)HALF * K * 2;
    const size_t tstep = 2 * hstep;
    const unsigned ldsw = (unsigned)wid * 1024u;
    const int aoff = lds_byte(wr * 64 + fr, fq * 8), boff = lds_byte(wc * 32 + fr, fq * 8);
#define PG8_SA(b, h) (((b) * 2 + (h)) * HTB)
#define PG8_SB(b, h) ((4 + (b) * 2 + (h)) * HTB)
#define PG8_STAGE(bufoff, gbase, voff) do { _Pragma("unroll") for (int _i = 0; _i < 2; ++_i) \
        __builtin_amdgcn_global_load_lds((const unsigned*)((const char*)(gbase) + (voff)[_i]), (LAS unsigned*)(lds + (bufoff) + ldsw + _i * 8192), 16, 0, 0); } while (0)
#define PG8_LDA(dst, b, h) do { _Pragma("unroll") for (int m = 0; m < 4; ++m) _Pragma("unroll") for (int k = 0; k < 2; ++k) dst[m][k] = *(const LAS bf16x8*)(lds + PG8_SA(b, h) + aoff + m * 2048 + k * 1024); } while (0)
#define PG8_LDB(dst, b, h) do { _Pragma("unroll") for (int n = 0; n < 2; ++n) _Pragma("unroll") for (int k = 0; k < 2; ++k) dst[n][k] = *(const LAS bf16x8*)(lds + PG8_SB(b, h) + boff + n * 2048 + k * 1024); } while (0)
#define PG8_MMA(ai, bj, At, Bt) do { __builtin_amdgcn_s_setprio(1); _Pragma("unroll") for (int m = 0; m < 4; ++m) _Pragma("unroll") for (int n = 0; n < 2; ++n) _Pragma("unroll") for (int k = 0; k < 2; ++k) \
        acc[ai][bj][m][n] = __builtin_amdgcn_mfma_f32_16x16x32_bf16(Bt[n][k], At[m][k], acc[ai][bj][m][n], 0, 0, 0); __builtin_amdgcn_s_setprio(0); } while (0)
#define PG8_WAIT_V(n) asm volatile("s_waitcnt vmcnt(" #n ")" ::: "memory")
#define PG8_WAIT_L(n) asm volatile("s_waitcnt lgkmcnt(" #n ")" ::: "memory")
#define PG8_BAR __builtin_amdgcn_s_barrier()
#define PG8_SCHED __builtin_amdgcn_sched_barrier(0)
    Unit cur, nxt; int ui = 0;
    if (!S.next(0, cur)) return;
    f32x4 acc[2][2][4][2];
#pragma unroll
    for (int a = 0; a < 2; ++a)
#pragma unroll
        for (int b = 0; b < 2; ++b)
#pragma unroll
            for (int m = 0; m < 4; ++m)
#pragma unroll
                for (int n = 0; n < 2; ++n) acc[a][b][m][n] = (f32x4){0.f, 0.f, 0.f, 0.f};
    bf16x8 At[4][2], B0[2][2], B1[2][2];
    const char* cA = (const char*)g.A + (size_t)cur.pm * tstep; const char* cB = (const char*)g.Bt + (size_t)cur.pn * tstep;
    PG8_STAGE(PG8_SB(0, 0), cB, voffB); PG8_STAGE(PG8_SA(0, 0), cA, voffA); PG8_STAGE(PG8_SB(0, 1), cB + hstep, voffB); PG8_STAGE(PG8_SA(0, 1), cA + hstep, voffA);
    if (wr == 1) PG8_BAR;
    PG8_WAIT_V(4); PG8_BAR;
    PG8_STAGE(PG8_SB(1, 0), cB + kstep, voffB); PG8_STAGE(PG8_SA(1, 0), cA + kstep, voffA); PG8_STAGE(PG8_SB(1, 1), cB + hstep + kstep, voffB);
    PG8_WAIT_V(6); PG8_BAR;
    for (;;) {
        const bool has_next = S.next(ui + 1, nxt);
        const char* nA = has_next ? (const char*)g.A + (size_t)nxt.pm * tstep : cA; const char* nB = has_next ? (const char*)g.Bt + (size_t)nxt.pn * tstep : cB;
        for (int t = 0; t < nt; t += 2) {
            const bool last = (t == nt - 2);
            const char* a1 = cA + (size_t)(t + 1) * kstep;
            const char* a2 = last ? nA : cA + (size_t)(t + 2) * kstep; const char* b2 = last ? nB : cB + (size_t)(t + 2) * kstep;
            const char* a3 = a2 + kstep; const char* b3 = b2 + kstep;
            PG8_LDB(B0, 0, 0); PG8_SCHED; PG8_LDA(At, 0, 0); PG8_STAGE(PG8_SA(1, 1), a1 + hstep, voffA);
            PG8_WAIT_L(8); PG8_BAR; PG8_WAIT_L(0); PG8_MMA(0, 0, At, B0); PG8_BAR; PG8_SCHED;
            PG8_LDB(B1, 0, 1); PG8_STAGE(PG8_SB(0, 0), b2, voffB);
            PG8_BAR; PG8_WAIT_L(0); PG8_MMA(0, 1, At, B1); PG8_BAR;
            PG8_LDA(At, 0, 1); PG8_STAGE(PG8_SA(0, 0), a2, voffA);
            PG8_BAR; PG8_WAIT_L(0); PG8_MMA(1, 0, At, B0); PG8_BAR; PG8_SCHED;
            PG8_STAGE(PG8_SB(0, 1), b2 + hstep, voffB);
            PG8_WAIT_V(6); PG8_BAR; PG8_MMA(1, 1, At, B1); PG8_BAR;
            PG8_LDB(B0, 1, 0); PG8_SCHED; PG8_LDA(At, 1, 0); PG8_STAGE(PG8_SA(0, 1), a2 + hstep, voffA);
            PG8_WAIT_L(8); PG8_BAR; PG8_WAIT_L(0); PG8_MMA(0, 0, At, B0); PG8_BAR; PG8_SCHED;
            PG8_LDB(B1, 1, 1); PG8_STAGE(PG8_SB(1, 0), b3, voffB);
            PG8_BAR; PG8_WAIT_L(0); PG8_MMA(0, 1, At, B1); PG8_BAR;
            PG8_LDA(At, 1, 1); PG8_STAGE(PG8_SA(1, 0), a3, voffA);
            PG8_BAR; PG8_WAIT_L(0); PG8_MMA(1, 0, At, B0); PG8_BAR; PG8_SCHED;
            PG8_STAGE(PG8_SB(1, 1), b3 + hstep, voffB);
            PG8_WAIT_V(6); PG8_BAR; PG8_MMA(1, 1, At, B1); PG8_BAR;
        }
        E(acc, cur, wr, wc, fr, fq);
        if (!has_next) break;
#pragma unroll
        for (int a = 0; a < 2; ++a)
#pragma unroll
            for (int b = 0; b < 2; ++b)
#pragma unroll
                for (int m = 0; m < 4; ++m)
#pragma unroll
                    for (int n = 0; n < 2; ++n) acc[a][b][m][n] = (f32x4){0.f, 0.f, 0.f, 0.f};
        cur = nxt; cA = nA; cB = nB; ++ui;
    }
    PG8_WAIT_V(0);
    if (wr == 0) PG8_BAR;
    PG8_BAR;
#undef PG8_SA
#undef PG8_SB
#undef PG8_STAGE
#undef PG8_LDA
#undef PG8_LDB
#undef PG8_MMA
#undef PG8_WAIT_V
#undef PG8_WAIT_L
#undef PG8_BAR
#undef PG8_SCHED
}

struct EpiF32 {
    static constexpr bool PERM = false;
    float* C; int ldc;
    __device__ __forceinline__ void operator()(const f32x4 (&acc)[2][2][4][2], const Unit& u, int wr, int wc, int fr, int fq) const {
        const int row0 = u.pm * BM + wr * 64 + fr, col0 = u.pn * BM + wc * 32 + 4 * fq;
#pragma unroll
        for (int ai = 0; ai < 2; ++ai)
#pragma unroll
            for (int m = 0; m < 4; ++m) { float* rowp = C + (size_t)(row0 + ai * HALF + m * 16) * ldc + col0;
#pragma unroll
                for (int bj = 0; bj < 2; ++bj)
#pragma unroll
                    for (int n = 0; n < 2; ++n) *(f32x4*)(rowp + bj * HALF + n * 16) = acc[ai][bj][m][n]; }
    }
};
struct EpiSwiGLU {
    static constexpr bool PERM = true;
    bf16_t* O;
    __device__ __forceinline__ void operator()(const f32x4 (&acc)[2][2][4][2], const Unit& u, int wr, int wc, int fr, int fq) const {
        const int row0 = u.pm * BM + wr * 64 + fr, col0 = u.pn * HALF + wc * 32 + 8 * fq;
#pragma unroll
        for (int ai = 0; ai < 2; ++ai)
#pragma unroll
            for (int m = 0; m < 4; ++m) {
                bf16_t* rowp = O + (size_t)(row0 + ai * HALF + m * 16) * DFF + col0;
                const f32x4 a0 = acc[ai][0][m][0], a1 = acc[ai][0][m][1], b0 = acc[ai][1][m][0], b1 = acc[ai][1][m][1];
                u32x4 pk;
                pk[0] = cvt_pk_bf16(siluf_(a0[0]) * b0[0], siluf_(a0[1]) * b0[1]);
                pk[1] = cvt_pk_bf16(siluf_(a0[2]) * b0[2], siluf_(a0[3]) * b0[3]);
                pk[2] = cvt_pk_bf16(siluf_(a1[0]) * b1[0], siluf_(a1[1]) * b1[1]);
                pk[3] = cvt_pk_bf16(siluf_(a1[2]) * b1[2], siluf_(a1[3]) * b1[3]);
                *(u32x4*)rowp = pk;
            }
    }
};
struct EpiResid {
    static constexpr bool PERM = false;
    float* X; const float* gate; float coef;
    __device__ __forceinline__ void operator()(const f32x4 (&acc)[2][2][4][2], const Unit& u, int wr, int wc, int fr, int fq) const {
        const int row0 = u.pm * BM + wr * 64 + fr, col0 = u.pn * BM + wc * 32 + 4 * fq;
        const int midx = u.pm < 32 ? 0 : 1 + ((u.pm - 32) >> 2);
        const float* g = gate + (size_t)midx * NMOD + col0;
        f32x4 gv[2][2];
#pragma unroll
        for (int bj = 0; bj < 2; ++bj)
#pragma unroll
            for (int n = 0; n < 2; ++n) gv[bj][n] = *(const f32x4*)(g + bj * HALF + n * 16) * coef;
#pragma unroll
        for (int ai = 0; ai < 2; ++ai)
#pragma unroll
            for (int m = 0; m < 4; ++m) { float* rowp = X + (size_t)(row0 + ai * HALF + m * 16) * DM + col0;
#pragma unroll
                for (int bj = 0; bj < 2; ++bj)
#pragma unroll
                    for (int n = 0; n < 2; ++n) { f32x4 xv = *(const f32x4*)(rowp + bj * HALF + n * 16); xv += gv[bj][n] * acc[ai][bj][m][n]; *(f32x4*)(rowp + bj * HALF + n * 16) = xv; } }
    }
};
}

__device__ __forceinline__ void transpose_tile(const float* src, int N, int k0, int n0src, bf16_t* dst, int K, int n0dst, float* tile  ) {
    const int tid = opaque_tid();
    __syncthreads();
#pragma unroll
    for (int i = 0; i < 2; ++i) {
        const int kk = (tid >> 4) + 32 * i, c4 = (tid & 15) * 4;
        const f32x4 v = *(const f32x4*)(src + (size_t)(k0 + kk) * N + n0src + c4);
        tile[kk * 65 + c4 + 0] = v[0]; tile[kk * 65 + c4 + 1] = v[1]; tile[kk * 65 + c4 + 2] = v[2]; tile[kk * 65 + c4 + 3] = v[3];
    }
    __syncthreads();
    const int nn = tid >> 3, kg = tid & 7;
    u32x4 pk;
#pragma unroll
    for (int j = 0; j < 4; ++j) pk[j] = cvt_pk_bf16(tile[(kg * 8 + 2 * j) * 65 + nn], tile[(kg * 8 + 2 * j + 1) * 65 + nn]);
    *(u32x4*)(dst + (size_t)(n0dst + nn) * K + k0 + kg * 8) = pk;
}

__device__ __forceinline__ void phase0(const P& p, unsigned char* smem) {
    const int tid = opaque_tid(), G = gridDim.x, bid = blockIdx.x;
    float* tile = (float*)smem;
    float* sc = (float*)(smem + 32768);
    float* part = (float*)(smem + 65536);
    for (int i = tid; i < 5 * 1024; i += 512) { const int r = i >> 10, k = i & 1023; const float v = r == 0 ? p.c_ctx[k] : p.c[(r - 1) * 1024 + k]; sc[i] = siluf_(v); }
    __syncthreads();
    for (int it = bid; it < 576; it += G) {
        const int l = it / 144, jb = it % 144, col = tid & 63, kg = tid >> 6;
        const float* w = p.w_mod + (size_t)l * 1024 * NMOD + (size_t)(kg * 128) * NMOD + jb * 64 + col;
        float a0 = 0.f, a1 = 0.f, a2 = 0.f, a3 = 0.f, a4 = 0.f;
#pragma unroll 8
        for (int k = 0; k < 128; ++k) { const float wv = w[(size_t)k * NMOD]; const int kk = kg * 128 + k;
            a0 += sc[kk] * wv; a1 += sc[1024 + kk] * wv; a2 += sc[2048 + kk] * wv; a3 += sc[3072 + kk] * wv; a4 += sc[4096 + kk] * wv; }
        __syncthreads();
        part[(kg * 5 + 0) * 64 + col] = a0; part[(kg * 5 + 1) * 64 + col] = a1; part[(kg * 5 + 2) * 64 + col] = a2; part[(kg * 5 + 3) * 64 + col] = a3; part[(kg * 5 + 4) * 64 + col] = a4;
        __syncthreads();
        if (tid < 320) { const int r = tid >> 6, cc = tid & 63; float s = p.b_mod[l * NMOD + jb * 64 + cc];
#pragma unroll
            for (int q = 0; q < 8; ++q) s += part[(q * 5 + r) * 64 + cc];
            p.mod[((size_t)l * 5 + r) * NMOD + jb * 64 + cc] = s; }
    }
    for (int it = bid; it < 8 * 1408; it += G) {
        const int mi = it / 1408, r = it % 1408, tk = r / 88, tn = r % 88;
        const int n0dst = tn * 64, pn = n0dst >> 8, w = n0dst & 255, bj = w >> 7, i0 = w & 127, n0src = bj * DFF + pn * 128 + i0;
        transpose_tile(p.ffn_w_in + (size_t)mi * 1024 * 5632, 5632, tk * 64, n0src, p.wt_ffn_in + (size_t)mi * 5632 * 1024, 1024, n0dst, tile);
    }
    for (int it = bid; it < 8 * 704; it += G) {
        const int mi = it / 704, r = it % 704, tk = r / 16, tn = r % 16;
        transpose_tile(p.ffn_w_out + (size_t)mi * DFF * 1024, 1024, tk * 64, tn * 64, p.wt_ffn_out + (size_t)mi * 1024 * DFF, DFF, tn * 64, tile);
    }
    for (int it = bid; it < 4 * 704; it += G) {
        const int mi = it / 704, r = it % 704, tk = r / 44, tn = r % 44;
        transpose_tile(p.w_in + (size_t)mi * 1024 * NPROJ, NPROJ, tk * 64, tn * 64, p.wt_in + (size_t)mi * NPROJ * 1024, 1024, tn * 64, tile);
    }
    for (int it = bid; it < 4 * 256; it += G) {
        const int mi = it / 256, r = it % 256, tk = r / 16, tn = r % 16;
        transpose_tile(p.w_out + (size_t)mi * 1024 * 1024, 1024, tk * 64, tn * 64, p.wt_out + (size_t)mi * 1024 * 1024, 1024, tn * 64, tile);
    }
    const int gt = bid * 512 + tid, GT = G * 512;
    for (int i = gt; i < 32768; i += GT) { const int t = i >> 5, pp = i & 31, f = pp & 15;
        const float inv = powf(10000.f, -(float)f / 16.f); const float pos = pp < 16 ? (float)(t >> 6) : (float)(t & 63); const float ang = pos * inv;
        p.rope[i] = make_float2(cosf(ang), sinf(ang)); }
    for (int i = gt; i < 262144; i += GT) { const int c = i & 63, dout = (i >> 6) & 63, n = (i >> 12) & 3, g = (i >> 14) & 1, d = (i >> 15) & 1, l = i >> 16;
        const float* src = g ? p.lru_w_i : p.lru_w_r;
        p.lruWt[i] = f2bf(src[((((size_t)l * 2 + d) * 4 + n) * 64 + c) * 64 + dout]); }
    for (int i = gt; i < M_TOK * DM / 4; i += GT) { const f32x4 v = i < M_P * DM / 4 ? ((const f32x4*)p.x_prompt)[i] : ((const f32x4*)p.x_sample)[i - M_P * DM / 4]; ((f32x4*)p.out)[i] = v; }
}

__device__ __forceinline__ void norm_phase(const P& p, int l, int s) {
    const int tid = opaque_tid(), lane = tid & 63, w = tid >> 6;
    const float* ng = p.norm_g + ((size_t)l * 3 + s) * DM;
    for (int row = blockIdx.x * 8 + w; row < M_TOK; row += gridDim.x * 8) {
        const int midx = row < M_P ? 0 : 1 + ((row - M_P) >> 10);
        const float* md = p.mod + ((size_t)l * 5 + midx) * NMOD + (3 * s) * DM;
        const float* x = p.out + (size_t)row * DM;
        f32x4 v[4]; float ss = 0.f;
#pragma unroll
        for (int i = 0; i < 4; ++i) { v[i] = *(const f32x4*)(x + lane * 4 + 256 * i); ss += v[i][0] * v[i][0] + v[i][1] * v[i][1] + v[i][2] * v[i][2] + v[i][3] * v[i][3]; }
#pragma unroll
        for (int o = 1; o < 64; o <<= 1) ss += __shfl_xor(ss, o);
        const float rinv = rsqrtf(ss * (1.f / DM) + 1e-6f);
#pragma unroll
        for (int i = 0; i < 4; ++i) { const int c = lane * 4 + 256 * i;
            const f32x4 g = *(const f32x4*)(ng + c), sh = *(const f32x4*)(md + c), scl = *(const f32x4*)(md + DM + c);
            const f32x4 y = v[i] * rinv * g * (scl + 1.f) + sh;
            u32x2 pk; pk[0] = cvt_pk_bf16(y[0], y[1]); pk[1] = cvt_pk_bf16(y[2], y[3]);
            *(u32x2*)(p.h + (size_t)row * DM + c) = pk; }
    }
}

constexpr int AT_BUF = 17920;
constexpr int AT_KT = 2 * AT_BUF;
constexpr int AT_BTAB = AT_KT + 2 * 18432;

template <int MODE>
__device__ __forceinline__ void attn_item(const P& p, int l, unsigned char* smem, int b, int h, int qb) {
    constexpr bool SAMPLE = (MODE == 2 || MODE == 3 || MODE == 5);
    constexpr bool RET = (MODE >= 4);
    const int tid = opaque_tid(), lane = tid & 63, w = tid >> 6, lr = lane & 15, lg = lane >> 4;
    const int rowbase = SAMPLE ? M_P + b * 1024 : b * 256;
    int qcol, kcol, vcol, ycol; const float *qgn = nullptr, *kgn = nullptr;
    if (MODE == 0 || MODE == 2) { qcol = 512 + h * 64; kcol = 768 + (h >> 1) * 64; vcol = 896 + (h >> 1) * 64; ycol = 256 + h * 64; qgn = p.gqa_qn + l * 64; kgn = p.gqa_kn + l * 64; }
    else if (MODE == 1 || MODE == 3) { qcol = 1024 + h * 64; kcol = 1280 + h * 64; vcol = 1536 + h * 64; ycol = 512 + h * 64; qgn = p.nat_qn + l * 64; kgn = p.nat_kn + l * 64; }
    else { qcol = 1792 + h * 64; kcol = 2048 + h * 64; vcol = 2304 + h * 64; ycol = 768 + h * 64; }
    float* btab = (float*)(smem + AT_BTAB);
    const float LOG2E = 1.44269504f;
    if (MODE == 3) { for (int i = tid; i < 465; i += 512) btab[i] = p.nat_bias[((size_t)l * 4 + h) * 465 + i] * LOG2E; }

    bf16x8 qf[2][2];
    int tq[2];
#pragma unroll
    for (int j = 0; j < 2; ++j) {
        tq[j] = qb * 256 + w * 32 + j * 16 + lr;
        const float* qrow = p.proj + (size_t)(rowbase + tq[j]) * NPROJ + qcol + lg * 8;
        f32x4 q0 = *(const f32x4*)qrow, q1 = *(const f32x4*)(qrow + 4), q2 = *(const f32x4*)(qrow + 32), q3 = *(const f32x4*)(qrow + 36);
        if (!RET) {
            float ss = 0.f;
#pragma unroll
            for (int jj = 0; jj < 4; ++jj) ss += q0[jj] * q0[jj] + q1[jj] * q1[jj] + q2[jj] * q2[jj] + q3[jj] * q3[jj];
            ss += __shfl_xor(ss, 16); ss += __shfl_xor(ss, 32);
            const float rinv = rsqrtf(ss * (1.f / 64.f) + 1e-6f);
            const float* gp = qgn + lg * 8;
            q0 = q0 * rinv * *(const f32x4*)gp; q1 = q1 * rinv * *(const f32x4*)(gp + 4); q2 = q2 * rinv * *(const f32x4*)(gp + 32); q3 = q3 * rinv * *(const f32x4*)(gp + 36);
        }
        if (MODE == 2) {
            const float2* rp = p.rope + tq[j] * 32 + lg * 4;
            const float2 c0 = rp[0], c1 = rp[1], c2 = rp[2], c3 = rp[3], c4 = rp[16], c5 = rp[17], c6 = rp[18], c7 = rp[19];
            float a, bb;
            a = q0[0]; bb = q0[1]; q0[0] = a * c0.x - bb * c0.y; q0[1] = a * c0.y + bb * c0.x;
            a = q0[2]; bb = q0[3]; q0[2] = a * c1.x - bb * c1.y; q0[3] = a * c1.y + bb * c1.x;
            a = q1[0]; bb = q1[1]; q1[0] = a * c2.x - bb * c2.y; q1[1] = a * c2.y + bb * c2.x;
            a = q1[2]; bb = q1[3]; q1[2] = a * c3.x - bb * c3.y; q1[3] = a * c3.y + bb * c3.x;
            a = q2[0]; bb = q2[1]; q2[0] = a * c4.x - bb * c4.y; q2[1] = a * c4.y + bb * c4.x;
            a = q2[2]; bb = q2[3]; q2[2] = a * c5.x - bb * c5.y; q2[3] = a * c5.y + bb * c5.x;
            a = q3[0]; bb = q3[1]; q3[0] = a * c6.x - bb * c6.y; q3[1] = a * c6.y + bb * c6.x;
            a = q3[2]; bb = q3[3]; q3[2] = a * c7.x - bb * c7.y; q3[3] = a * c7.y + bb * c7.x;
        }
        u32x4 t0, t1;
        t0[0] = cvt_pk_bf16(q0[0], q0[1]); t0[1] = cvt_pk_bf16(q0[2], q0[3]); t0[2] = cvt_pk_bf16(q1[0], q1[1]); t0[3] = cvt_pk_bf16(q1[2], q1[3]);
        t1[0] = cvt_pk_bf16(q2[0], q2[1]); t1[1] = cvt_pk_bf16(q2[2], q2[3]); t1[2] = cvt_pk_bf16(q3[0], q3[1]); t1[3] = cvt_pk_bf16(q3[2], q3[3]);
        qf[j][0] = __builtin_bit_cast(bf16x8, t0); qf[j][1] = __builtin_bit_cast(bf16x8, t1);
    }

    int ntiles, krlo = 0;
    if (MODE == 0 || MODE == 1 || MODE == 4) ntiles = 4;
    else if (MODE == 2) ntiles = 20;
    else if (MODE == 5) ntiles = 18;
    else { const int r0 = 4 * qb; krlo = min(max(r0 - 4, 0), 8); const int krhi = min(max(r0 + 3 - 4, 0), 8) + 7; ntiles = 4 + (krhi - krlo + 1); }
    float lgf = 0.f, lgb = 0.f;
    if (RET) { const float xf = p.ret_decay[(l * 2 + 0) * 4 + h], xb = p.ret_decay[(l * 2 + 1) * 4 + h];
        lgf = -log1pf(expf(-xf)) * LOG2E; lgb = -log1pf(expf(-xb)) * LOG2E; }

    f32x4 o[2][4];
#pragma unroll
    for (int j = 0; j < 2; ++j)
#pragma unroll
        for (int i = 0; i < 4; ++i) o[j][i] = (f32x4){0.f, 0.f, 0.f, 0.f};
    float m_run[2] = {-1e30f, -1e30f}, l_run[2] = {0.f, 0.f};
    f32x4 sacc[2][2];
#pragma unroll
    for (int j = 0; j < 2; ++j)
#pragma unroll
        for (int i = 0; i < 2; ++i) sacc[j][i] = (f32x4){0.f, 0.f, 0.f, 0.f};
    const int skey = tid >> 3, sdg = tid & 7;

    f32x4 rk0, rk1, rv0, rv1; float2 rc0, rc1, rc2, rc3;
    rc0 = rc1 = rc2 = rc3 = make_float2(1.f, 0.f);
    rk0 = rk1 = (f32x4){0.f, 0.f, 0.f, 0.f};

    auto tile_tk = [&](int kt) -> int { if (MODE == 3 && kt >= 4) return (krlo + kt - 4) * 64 + skey; return kt * 64 + skey; };
    auto load_tile = [&](int kt) {
        const int tk = tile_tk(kt);
        const float *ksrc = nullptr, *vsrc;
        if (MODE == 0 || MODE == 1 || MODE == 4) { ksrc = p.proj + (size_t)(rowbase + tk) * NPROJ; vsrc = ksrc + vcol + sdg * 8; ksrc += kcol + sdg * 8; }
        else if (MODE == 2) {
            if (kt < 16) { ksrc = p.proj + (size_t)(rowbase + tk) * NPROJ; vsrc = ksrc + vcol + sdg * 8; ksrc += kcol + sdg * 8;
                const float2* rp = p.rope + tk * 32 + sdg * 4; rc0 = rp[0]; rc1 = rp[1]; rc2 = rp[2]; rc3 = rp[3]; }
            else { const size_t off = ((((size_t)b * 4 + l) * 256 + (tk - 1024)) * 2 + (h >> 1)) * 64 + sdg * 8; ksrc = p.cbk + off; vsrc = p.cbv + off; }
        } else if (MODE == 3) {
            if (kt < 4) { const size_t off = ((((size_t)b * 4 + l) * 256 + tk) * 4 + h) * 64 + sdg * 8; ksrc = p.cck + off; vsrc = p.ccv + off; }
            else { ksrc = p.proj + (size_t)(rowbase + tk) * NPROJ; vsrc = ksrc + vcol + sdg * 8; ksrc += kcol + sdg * 8; }
        } else {
            if (kt < 16) { ksrc = p.proj + (size_t)(rowbase + tk) * NPROJ; vsrc = ksrc + vcol + sdg * 8; ksrc += kcol + sdg * 8; }
            else { vsrc = p.st_ret + ((((((size_t)b * 4 + l) * 2 + (kt - 16)) * 4 + h) * 64 + skey) * 64) + sdg * 8; }
        }
        rv0 = *(const f32x4*)vsrc; rv1 = *(const f32x4*)(vsrc + 4);
        if (ksrc) { rk0 = *(const f32x4*)ksrc; rk1 = *(const f32x4*)(ksrc + 4); }
    };
    auto store_tile = [&](int kt) {
        unsigned char* buf = smem + (kt & 1) * AT_BUF;
        bf16_t* Ks = (bf16_t*)buf; bf16_t* Vt = (bf16_t*)(buf + 9216);
        const int tk = tile_tk(kt);
        f32x4 k0 = rk0, k1 = rk1; const f32x4 v0 = rv0, v1 = rv1;
        bool donorm = !RET;
        if (MODE == 2 && kt >= 16) donorm = false;
        if (MODE == 3 && kt < 4) donorm = false;
        if (MODE == 5 && kt >= 16) {
#pragma unroll
            for (int j = 0; j < 4; ++j) { k0[j] = (sdg * 8 + j == skey) ? 1.f : 0.f; k1[j] = (sdg * 8 + 4 + j == skey) ? 1.f : 0.f; }
        }
        if (donorm) {
            float ss = 0.f;
#pragma unroll
            for (int j = 0; j < 4; ++j) ss += k0[j] * k0[j] + k1[j] * k1[j];
            ss += __shfl_xor(ss, 1); ss += __shfl_xor(ss, 2); ss += __shfl_xor(ss, 4);
            const float rinv = rsqrtf(ss * (1.f / 64.f) + 1e-6f);
            k0 = k0 * rinv * *(const f32x4*)(kgn + sdg * 8); k1 = k1 * rinv * *(const f32x4*)(kgn + sdg * 8 + 4);
        }
        if (MODE == 2) { if (kt < 16) {
            float a, bb;
            a = k0[0]; bb = k0[1]; k0[0] = a * rc0.x - bb * rc0.y; k0[1] = a * rc0.y + bb * rc0.x;
            a = k0[2]; bb = k0[3]; k0[2] = a * rc1.x - bb * rc1.y; k0[3] = a * rc1.y + bb * rc1.x;
            a = k1[0]; bb = k1[1]; k1[0] = a * rc2.x - bb * rc2.y; k1[1] = a * rc2.y + bb * rc2.x;
            a = k1[2]; bb = k1[3]; k1[2] = a * rc3.x - bb * rc3.y; k1[3] = a * rc3.y + bb * rc3.x;
        } }
        if (MODE == 0) { if ((h & 1) == 0) { const size_t off = ((((size_t)b * 4 + l) * 256 + tk) * 2 + (h >> 1)) * 64 + sdg * 8;
            *(f32x4*)(p.out + OFF_BK + off) = k0; *(f32x4*)(p.out + OFF_BK + off + 4) = k1; *(f32x4*)(p.out + OFF_BV + off) = v0; *(f32x4*)(p.out + OFF_BV + off + 4) = v1; } }
        if (MODE == 1) { const size_t off = ((((size_t)b * 4 + l) * 256 + tk) * 4 + h) * 64 + sdg * 8;
            *(f32x4*)(p.out + OFF_CK + off) = k0; *(f32x4*)(p.out + OFF_CK + off + 4) = k1; *(f32x4*)(p.out + OFF_CV + off) = v0; *(f32x4*)(p.out + OFF_CV + off + 4) = v1; }
        u32x4 pk; pk[0] = cvt_pk_bf16(k0[0], k0[1]); pk[1] = cvt_pk_bf16(k0[2], k0[3]); pk[2] = cvt_pk_bf16(k1[0], k1[1]); pk[3] = cvt_pk_bf16(k1[2], k1[3]);
        *(u32x4*)(Ks + skey * 72 + sdg * 8) = pk;
#pragma unroll
        for (int j = 0; j < 4; ++j) { Vt[(sdg * 8 + j) * 68 + skey] = f2bf(v0[j]); Vt[(sdg * 8 + 4 + j) * 68 + skey] = f2bf(v1[j]); }
        if (MODE == 4) {
            bf16_t* Ktf = (bf16_t*)(smem + AT_KT + (kt & 1) * 18432); bf16_t* Ktb = Ktf + 64 * 72;
            const float wf = 0.125f * fexp2((float)(255 - tk) * lgf), wb = 0.125f * fexp2((float)tk * lgb);
#pragma unroll
            for (int j = 0; j < 4; ++j) { Ktf[(sdg * 8 + j) * 72 + skey] = f2bf(k0[j] * wf); Ktf[(sdg * 8 + 4 + j) * 72 + skey] = f2bf(k1[j] * wf);
                Ktb[(sdg * 8 + j) * 72 + skey] = f2bf(k0[j] * wb); Ktb[(sdg * 8 + 4 + j) * 72 + skey] = f2bf(k1[j] * wb); }
        }
    };

    __syncthreads();
    load_tile(0);
    for (int kt = 0; kt < ntiles; ++kt) {
        store_tile(kt);
        if (kt + 1 < ntiles) load_tile(kt + 1);
        __syncthreads();
        const unsigned char* buf = smem + (kt & 1) * AT_BUF;
        const bf16_t* Ks = (const bf16_t*)buf; const bf16_t* Vt = (const bf16_t*)(buf + 9216);
        f32x4 s[2][4];
#pragma unroll
        for (int ks = 0; ks < 4; ++ks) {
            s[0][ks] = (f32x4){0.f, 0.f, 0.f, 0.f}; s[1][ks] = (f32x4){0.f, 0.f, 0.f, 0.f};
#pragma unroll
            for (int st = 0; st < 2; ++st) { const bf16x8 kf = *(const bf16x8*)(Ks + (16 * ks + lr) * 72 + lg * 8 + 32 * st);
                s[0][ks] = MFMA16(kf, qf[0][st], s[0][ks]); s[1][ks] = MFMA16(kf, qf[1][st], s[1][ks]); }
        }
#pragma unroll
        for (int j = 0; j < 2; ++j) {
            if (!RET) {
                const float SC = 0.125f * LOG2E;
                float mx = -1e30f;
                const int nr = tq[j] >> 6, ncq = tq[j] & 63;
                const int rs = min(max(nr - 4, 0), 8), cs = min(max(ncq - 8, 0), 48);
#pragma unroll
                for (int ks = 0; ks < 4; ++ks)
#pragma unroll
                    for (int i = 0; i < 4; ++i) {
                        float v = s[j][ks][i] * SC;
                        if (MODE == 3) { if (kt >= 4) {
                            const int kr = krlo + kt - 4, kc = 16 * ks + lg * 4 + i;
                            const bool valid = (kr >= rs) && (kr < rs + 8) && (kc >= cs) && (kc < cs + 16);
                            const int bi = valid ? (kr - nr + 7) * 31 + (kc - ncq + 15) : 0;
                            v = valid ? v + btab[bi] : -1e30f; } }
                        s[j][ks][i] = v; mx = fmaxf(mx, v);
                    }
                mx = fmaxf(mx, __shfl_xor(mx, 16)); mx = fmaxf(mx, __shfl_xor(mx, 32));
                const float mnew = fmaxf(m_run[j], mx), alpha = fexp2(m_run[j] - mnew);
                m_run[j] = mnew; l_run[j] *= alpha;
#pragma unroll
                for (int dt = 0; dt < 4; ++dt) o[j][dt] *= alpha;
#pragma unroll
                for (int ks = 0; ks < 4; ++ks)
#pragma unroll
                    for (int i = 0; i < 4; ++i) { const float pv = fexp2(s[j][ks][i] - mnew); l_run[j] += pv; s[j][ks][i] = pv; }
            } else {
                if (MODE == 5 && kt >= 16) {
                    const float scl = kt == 16 ? fexp2((float)(tq[j] + 1) * lgf) : fexp2((float)(1024 - tq[j]) * lgb);
#pragma unroll
                    for (int ks = 0; ks < 4; ++ks) s[j][ks] *= scl;
                } else {
#pragma unroll
                    for (int ks = 0; ks < 4; ++ks)
#pragma unroll
                        for (int i = 0; i < 4; ++i) { const int ts = kt * 64 + 16 * ks + lg * 4 + i; const int df = tq[j] - ts;
                            const float dec = df > 0 ? fexp2((float)df * lgf) : (df < 0 ? fexp2((float)(-df) * lgb) : 2.f);
                            s[j][ks][i] *= 0.125f * dec; }
                }
            }
        }
#pragma unroll
        for (int kp = 0; kp < 2; ++kp) {
            bf16x8 pf[2];
#pragma unroll
            for (int j = 0; j < 2; ++j) {
                u32x4 pk; pk[0] = cvt_pk_bf16(s[j][2 * kp][0], s[j][2 * kp][1]); pk[1] = cvt_pk_bf16(s[j][2 * kp][2], s[j][2 * kp][3]);
                pk[2] = cvt_pk_bf16(s[j][2 * kp + 1][0], s[j][2 * kp + 1][1]); pk[3] = cvt_pk_bf16(s[j][2 * kp + 1][2], s[j][2 * kp + 1][3]);
                pf[j] = __builtin_bit_cast(bf16x8, pk);
            }
#pragma unroll
            for (int dt = 0; dt < 4; ++dt) {
                const bf16_t* vp = Vt + (16 * dt + lr) * 68 + 32 * kp + lg * 4;
                const u32x2 lo = *(const u32x2*)vp, hi = *(const u32x2*)(vp + 16);
                u32x4 vv; vv[0] = lo[0]; vv[1] = lo[1]; vv[2] = hi[0]; vv[3] = hi[1];
                const bf16x8 vf = __builtin_bit_cast(bf16x8, vv);
                o[0][dt] = MFMA16(vf, pf[0], o[0][dt]); o[1][dt] = MFMA16(vf, pf[1], o[1][dt]);
            }
        }
        if (MODE == 4) {
            const bf16_t* Ktf = (const bf16_t*)(smem + AT_KT + (kt & 1) * 18432); const bf16_t* Ktb = Ktf + 64 * 72;
            const int dt = w >> 1, e0 = 2 * (w & 1);
#pragma unroll
            for (int st = 0; st < 2; ++st) {
                const bf16x8 af = *(const bf16x8*)(Ktf + (16 * dt + lr) * 72 + lg * 8 + 32 * st), ab = *(const bf16x8*)(Ktb + (16 * dt + lr) * 72 + lg * 8 + 32 * st);
#pragma unroll
                for (int ee = 0; ee < 2; ++ee) {
                    const bf16_t* vp = Vt + (16 * (e0 + ee) + lr) * 68 + lg * 8 + 32 * st;
                    const u32x2 lo = *(const u32x2*)vp, hi = *(const u32x2*)(vp + 4);
                    u32x4 vv; vv[0] = lo[0]; vv[1] = lo[1]; vv[2] = hi[0]; vv[3] = hi[1];
                    const bf16x8 vf = __builtin_bit_cast(bf16x8, vv);
                    sacc[0][ee] = MFMA16(af, vf, sacc[0][ee]); sacc[1][ee] = MFMA16(ab, vf, sacc[1][ee]);
                }
            }
        }
    }
#pragma unroll
    for (int j = 0; j < 2; ++j) {
        bf16_t* yrow = p.ycat + (size_t)(rowbase + tq[j]) * DM + ycol + lg * 4;
        if (!RET) {
            float ls = l_run[j];
            ls += __shfl_xor(ls, 16); ls += __shfl_xor(ls, 32);
            const float inv = 1.f / ls;
#pragma unroll
            for (int dt = 0; dt < 4; ++dt) { u32x2 pk; pk[0] = cvt_pk_bf16(o[j][dt][0] * inv, o[j][dt][1] * inv); pk[1] = cvt_pk_bf16(o[j][dt][2] * inv, o[j][dt][3] * inv); *(u32x2*)(yrow + 16 * dt) = pk; }
        } else {
            float sm = 0.f;
#pragma unroll
            for (int dt = 0; dt < 4; ++dt) sm += o[j][dt][0] + o[j][dt][1] + o[j][dt][2] + o[j][dt][3];
            sm += __shfl_xor(sm, 16); sm += __shfl_xor(sm, 32);
            const float mu = sm * (1.f / 64.f);
            float vs = 0.f;
#pragma unroll
            for (int dt = 0; dt < 4; ++dt)
#pragma unroll
                for (int i = 0; i < 4; ++i) { const float dlt = o[j][dt][i] - mu; vs += dlt * dlt; }
            vs += __shfl_xor(vs, 16); vs += __shfl_xor(vs, 32);
            const float rstd = rsqrtf(vs * (1.f / 64.f) + 1e-6f);
            const float* gdp = p.proj + (size_t)(rowbase + tq[j]) * NPROJ + 2560 + h * 64 + lg * 4;
            const float* gnp = p.ret_gn + l * 256 + h * 64 + lg * 4;
#pragma unroll
            for (int dt = 0; dt < 4; ++dt) {
                const f32x4 gd = *(const f32x4*)(gdp + 16 * dt), gn = *(const f32x4*)(gnp + 16 * dt);
                float y0 = (o[j][dt][0] - mu) * rstd * gn[0] * siluf_(gd[0]), y1 = (o[j][dt][1] - mu) * rstd * gn[1] * siluf_(gd[1]);
                float y2 = (o[j][dt][2] - mu) * rstd * gn[2] * siluf_(gd[2]), y3 = (o[j][dt][3] - mu) * rstd * gn[3] * siluf_(gd[3]);
                u32x2 pk; pk[0] = cvt_pk_bf16(y0, y1); pk[1] = cvt_pk_bf16(y2, y3); *(u32x2*)(yrow + 16 * dt) = pk;
            }
        }
    }
    if (MODE == 4) {
        const int dt = w >> 1, e0 = 2 * (w & 1);
#pragma unroll
        for (int dir = 0; dir < 2; ++dir) {
            float* so = p.out + OFF_RET + ((((size_t)b * 4 + l) * 2 + dir) * 4 + h) * 4096;
#pragma unroll
            for (int ee = 0; ee < 2; ++ee)
#pragma unroll
                for (int i = 0; i < 4; ++i) so[(16 * dt + 4 * lg + i) * 64 + 16 * (e0 + ee) + lr] = sacc[dir][ee][i];
        }
    }
}

__device__ __forceinline__ void lru_item(const P& p, int l, unsigned char* smem, int bg, int n, int d, volatile LAS unsigned* xbw) {
    const int tid = opaque_tid(), lane = tid & 63, w = tid >> 6, lr = lane & 15, lg = lane >> 4;
    const bool sample = bg >= 32;
    const int T = sample ? 1024 : 256, rowbase = sample ? M_P + (bg - 32) * 1024 : bg * 256, nch = T >> 7;
    bf16_t* Wt = (bf16_t*)smem;
    bf16_t* xcb = (bf16_t*)(smem + 18432);
    float* uL = (float*)(smem + 36864);
    float* aL = (float*)(smem + 71680);
    float* segA = (float*)(smem + 106496);
    float* segB = segA + 512;
    const int ch = lane;
    const int c4 = (tid & 15) * 4;
    const float LOG2E = 1.44269504f;
    const f32x4 cw0 = *(const f32x4*)(p.conv_w + ((size_t)l * 4 + 0) * 256 + n * 64 + c4), cw1 = *(const f32x4*)(p.conv_w + ((size_t)l * 4 + 1) * 256 + n * 64 + c4),
          cw2 = *(const f32x4*)(p.conv_w + ((size_t)l * 4 + 2) * 256 + n * 64 + c4), cw3 = *(const f32x4*)(p.conv_w + ((size_t)l * 4 + 3) * 256 + n * 64 + c4),
          cbv = *(const f32x4*)(p.conv_b + (size_t)l * 256 + n * 64 + c4);
    float* hd = p.hf + (size_t)d * M_TOK * 256;
    __syncthreads();
#pragma unroll
    for (int i = 0; i < 2; ++i) { const u32x4 v = *(const u32x4*)(p.lruWt + ((((size_t)l * 2 + d) * 2 + i) * 4 + n) * 4096 + tid * 8);
        *(u32x4*)(Wt + (i * 64 + (tid >> 3)) * 72 + (tid & 7) * 8) = v; }
    float sp[4], br[4], bi[4];
#pragma unroll
    for (int ct = 0; ct < 4; ++ct) { const int cidx = (l * 2 + d) * 256 + n * 64 + 16 * ct + lr;
        sp[ct] = log1pf(expf(-p.lru_lambda[cidx])); br[ct] = p.lru_b_r[cidx]; bi[ct] = p.lru_b_i[cidx]; }
    float carry = sample ? p.st_lru[(((size_t)(bg - 32) * 4 + l) * 2 + d) * 256 + n * 64 + ch] : 0.f;
    f32x4 xin[7];
    auto load_chunk = [&](int t0) {
#pragma unroll
        for (int i = 0; i < 7; ++i) {
            const int t = t0 + 4 * (tid >> 4) - 2 + i;
            const f32x4 z = {0.f, 0.f, 0.f, 0.f};
            xin[i] = (t >= 0 && t < T) ? *(const f32x4*)(p.proj + (size_t)(rowbase + t) * NPROJ + n * 64 + c4) : z;
        }
    };
    load_chunk(d == 0 ? 0 : (nch - 1) * 128);
    for (int cc = 0; cc < nch; ++cc) {
        const int ci = d == 0 ? cc : nch - 1 - cc, t0 = ci * 128;
        __syncthreads();
#pragma unroll
        for (int k = 0; k < 4; ++k) {
            const int tt = 4 * (tid >> 4) + k;
            const f32x4 acc = cbv + cw0 * xin[k] + cw1 * xin[k + 1] + cw2 * xin[k + 2] + cw3 * xin[k + 3];
            *(f32x4*)(uL + tt * 68 + c4) = acc;
            u32x2 pk; pk[0] = cvt_pk_bf16(acc[0], acc[1]); pk[1] = cvt_pk_bf16(acc[2], acc[3]);
            *(u32x2*)(xcb + tt * 72 + c4) = pk;
        }
        if (cc + 1 < nch) load_chunk(d == 0 ? t0 + 128 : t0 - 128);
        __syncthreads();
        f32x4 acc[2][4];
#pragma unroll
        for (int g = 0; g < 2; ++g)
#pragma unroll
            for (int ct = 0; ct < 4; ++ct) acc[g][ct] = (f32x4){0.f, 0.f, 0.f, 0.f};
#pragma unroll
        for (int st = 0; st < 2; ++st) {
            const bf16x8 af = *(const bf16x8*)(xcb + (16 * w + lr) * 72 + lg * 8 + 32 * st);
#pragma unroll
            for (int g = 0; g < 2; ++g)
#pragma unroll
                for (int ct = 0; ct < 4; ++ct) { const bf16x8 bf = *(const bf16x8*)(Wt + (g * 64 + 16 * ct + lr) * 72 + lg * 8 + 32 * st); acc[g][ct] = MFMA16(af, bf, acc[g][ct]); }
        }
#pragma unroll
        for (int ct = 0; ct < 4; ++ct)
#pragma unroll
            for (int i = 0; i < 4; ++i) {
                const int tok = 16 * w + lg * 4 + i, dout = 16 * ct + lr;
                const float r = __builtin_amdgcn_rcpf(1.f + fexp2(-(acc[0][ct][i] + br[ct]) * LOG2E)), ig = __builtin_amdgcn_rcpf(1.f + fexp2(-(acc[1][ct][i] + bi[ct]) * LOG2E));
                const float la = -8.f * r * sp[ct], a = fexp2(la * LOG2E), xc = uL[tok * 68 + dout];
                const float x2 = 2.f * la;
                const float em = -x2 * (1.f + x2 * (0.5f + x2 * (0.16666667f + x2 * (0.041666668f + x2 * (0.0083333333f + x2 * (0.0013888889f + x2 * 0.0001984127f))))));
                const float u = __builtin_amdgcn_sqrtf(em) * ig * xc;
                aL[tok * 68 + dout] = a; uL[tok * 68 + dout] = u;
            }
        __syncthreads();
        const int seg = d == 0 ? w : 7 - w;
        { float A = 1.f, Bv = 0.f;
#pragma unroll
          for (int k = 0; k < 16; ++k) { const int tok = 16 * w + (d == 0 ? k : 15 - k); const float a = aL[tok * 68 + ch], u = uL[tok * 68 + ch]; Bv = a * Bv + u; A *= a; }
          segA[seg * 64 + ch] = A; segB[seg * 64 + ch] = Bv; }
        __syncthreads();
        float hin = carry, hall = carry;
#pragma unroll
        for (int sgi = 0; sgi < 8; ++sgi) { if (sgi == seg) hin = hall; hall = segA[sgi * 64 + ch] * hall + segB[sgi * 64 + ch]; }
        carry = hall;
        float hh = hin;
#pragma unroll
        for (int k = 0; k < 16; ++k) {
            const int tok = 16 * w + (d == 0 ? k : 15 - k); const float a = aL[tok * 68 + ch], u = uL[tok * 68 + ch]; hh = a * hh + u;
            hd[(size_t)(rowbase + t0 + tok) * 256 + n * 64 + ch] = hh;
        }
    }
    if (!sample && w == 0) p.out[OFF_LRU + (((size_t)bg * 4 + l) * 2 + d) * 256 + n * 64 + ch] = carry;
    __threadfence();
    __syncthreads();
    if (tid == 0) xbw[3] = __hip_atomic_fetch_add(p.bar + XCD_BAR_WORDS + 512 + (l * 36 + bg) * 4 + n, 1u, __ATOMIC_RELAXED, __HIP_MEMORY_SCOPE_AGENT);
    __syncthreads();
    if (xbw[3] == 1u) {
        __builtin_amdgcn_fence(__ATOMIC_ACQUIRE, "agent");
        const float* h0 = p.hf, *h1 = p.hf + (size_t)M_TOK * 256;
        for (int e = tid; e < T * 16; e += 512) {
            const int t = e >> 4, q4 = (e & 15) * 4; const size_t row = (size_t)(rowbase + t);
            const f32x4 a = *(const f32x4*)(h0 + row * 256 + n * 64 + q4), bq = *(const f32x4*)(h1 + row * 256 + n * 64 + q4), ga = *(const f32x4*)(p.proj + row * NPROJ + 256 + n * 64 + q4);
            float y[4];
#pragma unroll
            for (int i = 0; i < 4; ++i) { const float g = ga[i]; const float z = 0.7978845608f * (g + 0.044715f * g * g * g);
                const float th = 1.f - 2.f * __builtin_amdgcn_rcpf(1.f + fexp2(2.f * LOG2E * z));
                y[i] = (a[i] + bq[i]) * 0.5f * g * (1.f + th); }
            u32x2 pk; pk[0] = cvt_pk_bf16(y[0], y[1]); pk[1] = cvt_pk_bf16(y[2], y[3]);
            *(u32x2*)(p.ycat + row * DM + n * 64 + q4) = pk;
        }
    }
}

constexpr int MIX_ITEMS = 864;
__device__ __forceinline__ void mixer_phase(const P& p, int l, unsigned char* smem, volatile LAS unsigned* xbw) {
    unsigned* ctr = p.bar + XCD_BAR_WORDS + 64 * l;
    int it = blockIdx.x;
    for (;;) {
        if (it >= MIX_ITEMS) break;
        if (it < 32) lru_item(p, l, smem, 32 + (it >> 3), (it >> 1) & 3, it & 1, xbw);
        else if (it < 96) { const int i = it - 32; attn_item<2>(p, l, smem, i >> 4, (i >> 2) & 3, i & 3); }
        else if (it < 160) { const int i = it - 96; attn_item<5>(p, l, smem, i >> 4, (i >> 2) & 3, i & 3); }
        else if (it < 224) { const int i = it - 160; attn_item<3>(p, l, smem, i >> 4, (i >> 2) & 3, i & 3); }
        else if (it < 480) { const int i = it - 224; lru_item(p, l, smem, i >> 3, (i >> 1) & 3, i & 1, xbw); }
        else if (it < 608) { const int i = it - 480; attn_item<0>(p, l, smem, i >> 2, i & 3, 0); }
        else if (it < 736) { const int i = it - 608; attn_item<1>(p, l, smem, i >> 2, i & 3, 0); }
        else { const int i = it - 736; attn_item<4>(p, l, smem, i >> 2, i & 3, 0); }
        __syncthreads();
        if (threadIdx.x == 0) xbw[2] = gridDim.x + __hip_atomic_fetch_add(ctr, 1u, __ATOMIC_RELAXED, __HIP_MEMORY_SCOPE_AGENT);
        __syncthreads();
        it = (int)xbw[2];
    }
}

__global__ void __launch_bounds__(512, 2) mega(P p) {
    extern __shared__ __attribute__((aligned(16))) unsigned char smem[];
    cg::grid_group grid = cg::this_grid();
    LAS unsigned char* lds = (LAS unsigned char*)smem;
    volatile LAS unsigned* xbw = (volatile LAS unsigned*)(lds + (LDS_BYTES - 16));
    if (threadIdx.x == 0) { xbw[0] = 0u; xbw[1] = 0u; }
    __syncthreads();
    const XcdBarrier xb = xcd_barrier_post(p.bar, xbw);
    phase0(p, smem);
    grid.sync();
#define GSYNC() xcd_barrier(xb)
    pg8::StaticOrder S;
    for (int l = 0; l < 4; ++l) {
        for (int s = 0; s < 3; ++s) {
            norm_phase(p, l, s);
            GSYNC();
            pg8::Gemm g2; float coef;
            if (s != 1) {
                const int sl = s >> 1;
                pg8::Gemm g{p.h, p.wt_ffn_in + ((size_t)l * 2 + sl) * 5632 * 1024, M_TOK, 5632, 1024};
                S.init(M_TOK, 5632, gridDim.x, blockIdx.x);
                pg8::gemm_phase(lds, g, S, pg8::EpiSwiGLU{p.act});
                GSYNC();
                g2 = pg8::Gemm{p.act, p.wt_ffn_out + ((size_t)l * 2 + sl) * 1024 * DFF, M_TOK, 1024, DFF}; coef = 0.5f;
            } else {
                pg8::Gemm g{p.h, p.wt_in + (size_t)l * NPROJ * 1024, M_TOK, NPROJ, 1024};
                S.init(M_TOK, NPROJ, gridDim.x, blockIdx.x);
                pg8::gemm_phase(lds, g, S, pg8::EpiF32{p.proj, NPROJ});
                GSYNC();
                mixer_phase(p, l, smem, xbw);
                GSYNC();
                g2 = pg8::Gemm{p.ycat, p.wt_out + (size_t)l * 1024 * 1024, M_TOK, 1024, 1024}; coef = 1.0f;
            }
            S.init(M_TOK, 1024, gridDim.x, blockIdx.x);
            pg8::gemm_phase(lds, g2, S, pg8::EpiResid{p.out, p.mod + (size_t)l * 5 * NMOD + (3 * s + 2) * DM, coef});
            GSYNC();
        }
    }
}

extern "C" void kernel_launch(void* const* d_in, const int* in_sizes, int n_in, void* d_out, int out_size, void* d_ws, size_t ws_size, hipStream_t stream) {
    static int grid_blocks = 0;
    if (!grid_blocks) {
        (void)hipFuncSetAttribute((const void*)mega, hipFuncAttributeMaxDynamicSharedMemorySize, LDS_BYTES);
        int dev = 0, cus = 0, per_cu = 0;
        (void)hipGetDevice(&dev);
        (void)hipDeviceGetAttribute(&cus, hipDeviceAttributeMultiprocessorCount, dev);
        (void)hipOccupancyMaxActiveBlocksPerMultiprocessor(&per_cu, mega, 512, LDS_BYTES);
        if (per_cu > 1) per_cu = 1;
        grid_blocks = cus * per_cu;
        if (grid_blocks <= 0) grid_blocks = 256;
    }
    P p{};
    const float** pf = (const float**)&p;
    for (int i = 0; i < 31; ++i) pf[i] = (const float*)d_in[i];
    p.out = (float*)d_out;
    char* ws = (char*)d_ws; size_t off = 0;
    auto carve = [&](size_t bytes) { char* r = ws + off; off += (bytes + 255) & ~(size_t)255; return r; };
    p.wt_ffn_in = (bf16_t*)carve((size_t)8 * 5632 * 1024 * 2);
    p.wt_ffn_out = (bf16_t*)carve((size_t)8 * 1024 * DFF * 2);
    p.wt_in = (bf16_t*)carve((size_t)4 * NPROJ * 1024 * 2);
    p.wt_out = (bf16_t*)carve((size_t)4 * 1024 * 1024 * 2);
    p.lruWt = (bf16_t*)carve((size_t)262144 * 2);
    p.mod = (float*)carve((size_t)4 * 5 * NMOD * 4);
    p.rope = (float2*)carve((size_t)32768 * 8);
    p.h = (bf16_t*)carve((size_t)M_TOK * DM * 2);
    p.act = (bf16_t*)carve((size_t)M_TOK * DFF * 2);
    p.ycat = (bf16_t*)carve((size_t)M_TOK * DM * 2);
    p.proj = (float*)carve((size_t)M_TOK * NPROJ * 4);
    p.hf = (float*)carve((size_t)2 * M_TOK * 256 * 4);
    p.bar = (unsigned*)carve((size_t)5120 * 4);
    (void)hipMemsetAsync(p.bar, 0, (size_t)5120 * 4, stream);
    void* args[] = {&p};
    hipError_t e = hipLaunchCooperativeKernel((void*)mega, dim3(grid_blocks), dim3(512), args, LDS_BYTES, stream);
    if (e != hipSuccess) fprintf(stderr, "cooperative launch failed: %s (grid %d)\n", hipGetErrorString(e), grid_blocks);
}
```
